# Optimizing an MI355X kernel written in HIP

```python
import jax
import jax.numpy as jnp
from jax import lax
import numpy as np

D_MODEL = 2048
BATCH = 8
SEQ = 4096
DEPTH = 2

MIX_HALF = D_MODEL // 2
HG_DK = 128
HG_HEADS = MIX_HALF // HG_DK
HG_DV = MIX_HALF // HG_HEADS
HG_CHUNK = 64
SW_DH = 128
SW_HEADS = MIX_HALF // SW_DH
SW_KV_HEADS = 2
SW_WINDOW = 128
NSA_DH = 128
NSA_HEADS = MIX_HALF // NSA_DH
NSA_KV_HEADS = 2
NSA_CMP_LEN = 32
NSA_CMP_STRIDE = 16
NSA_CMP_HIDDEN = 128
NSA_SEL_LEN = 64
NSA_N_SEL = 8
NSA_WINDOW = 512
NSA_Q_BLOCK = 64
RET_DK = 128
RET_DV = 256
RET_HEADS = MIX_HALF // RET_DV
RET_CHUNK = 128
RET_THETA_BASE = 10000.0
MOE_GROUPS = 4
MOE_EXPERTS_PER_GROUP = 8
MOE_EXPERTS = MOE_GROUPS * MOE_EXPERTS_PER_GROUP
MOE_TOPK = 2
MOE_DFF = D_MODEL // 2
MOE_ROW_BLOCK = 128
RMS_EPS = 1e-6

AB_SIZES = (HG_HEADS * HG_DK, HG_HEADS * HG_DK, HG_HEADS * HG_DV, HG_HEADS * HG_DV,
            SW_HEADS * SW_DH, SW_KV_HEADS * SW_DH, SW_KV_HEADS * SW_DH)
AB_OUT = HG_HEADS * HG_DV + SW_HEADS * SW_DH
CD_SIZES = ((NSA_HEADS * NSA_DH,) + (NSA_KV_HEADS * NSA_DH,) * 6 + (NSA_HEADS * 3,)
            + (RET_HEADS * RET_DK, RET_HEADS * RET_DK, RET_HEADS * RET_DV, RET_HEADS * RET_DV))
CD_OUT = NSA_HEADS * NSA_DH + RET_HEADS * RET_DV

kernel_name = "hybrid_hgrn2_swa_nsa_retention_hmoe"


def rmsnorm(x, w):
    x32 = x.astype(jnp.float32)
    y = x32 * lax.rsqrt(jnp.mean(x32 * x32, axis=-1, keepdims=True) + RMS_EPS)
    return (y * w.astype(jnp.float32)).astype(x.dtype)


def head_rmsnorm(o, w):
    *lead, H, d = o.shape
    y = o * lax.rsqrt(jnp.mean(o * o, axis=-1, keepdims=True) + RMS_EPS)
    return y.reshape(*lead, H * d) * w.astype(jnp.float32)


def head_layernorm(o, w):
    *lead, H, d = o.shape
    c = o - jnp.mean(o, axis=-1, keepdims=True)
    y = c * lax.rsqrt(jnp.mean(c * c, axis=-1, keepdims=True) + RMS_EPS)
    return y.reshape(*lead, H * d) * w.astype(jnp.float32)


def split_cols(a, sizes):
    offsets, acc = [], 0
    for s in sizes[:-1]:
        acc += s
        offsets.append(acc)
    return jnp.split(a, offsets, axis=-1)


def masked_softmax(s, mask):
    s = jnp.where(mask, s, -jnp.inf)
    m = jnp.max(s, axis=-1, keepdims=True)
    m = jnp.where(jnp.isfinite(m), m, 0.0)
    e = jnp.exp(s - m)
    z = jnp.sum(e, axis=-1, keepdims=True)
    return e / jnp.where(z > 0, z, 1.0)


def hgrn2_recurrence(q, f_logit, i, lb):
    B, T, H, dk = q.shape
    dv = i.shape[-1]
    C = HG_CHUNK
    N = T // C
    f = lb + (1.0 - lb) * jax.nn.sigmoid(f_logit.astype(jnp.float32))
    log_f = jnp.log(f)
    k = 1.0 - f

    def to_chunks(a):
        return a.astype(jnp.float32).reshape(B, N, C, H, a.shape[-1]).transpose(1, 0, 2, 3, 4)

    causal = jnp.tril(jnp.ones((C, C), dtype=bool))[None, :, :, None, None]

    def step(S, inp):
        qc, kc, vc, lf = inp
        b = jnp.cumsum(lf, axis=1)
        o_inter = jnp.einsum('bthd,bhde->bthe', qc * jnp.exp(b), S)
        decay = jnp.exp(jnp.where(causal, b[:, :, None] - b[:, None, :], -jnp.inf))
        a = jnp.einsum('btshd,bshd->bhts', qc[:, :, None] * decay, kc)
        o_intra = jnp.einsum('bhts,bshe->bthe', a, vc)
        b_end = b[:, -1]
        S = jnp.exp(b_end)[..., None] * S + jnp.einsum(
            'bshd,bshe->bhde', kc * jnp.exp(b_end[:, None] - b), vc)
        return S, o_inter + o_intra

    S0 = jnp.zeros((B, H, dk, dv), jnp.float32)
    _, o = lax.scan(step, S0, (to_chunks(q), to_chunks(k), to_chunks(i), to_chunks(log_f)))
    return o.transpose(1, 0, 2, 3, 4).reshape(B, T, H, dv)


def sliding_window_sink_attention(q, k, v, sinks):
    B, T, Hq, d = q.shape
    G = k.shape[2]
    R = Hq // G
    W = SW_WINDOW
    nb = T // W
    qb = q.reshape(B, nb, W, G, R, d)

    def band(a):
        ap = jnp.pad(a, ((0, 0), (W, 0), (0, 0), (0, 0))).reshape(B, nb + 1, W, G, d)
        return jnp.concatenate([ap[:, :-1], ap[:, 1:]], axis=2)

    kb, vb = band(k), band(v)
    s = jnp.einsum('bnqgrd,bnkgd->bngrqk', qb, kb, preferred_element_type=jnp.float32) * (d ** -0.5)
    rel = jnp.arange(W)[:, None] + W - jnp.arange(2 * W)[None, :]
    kpos = (jnp.arange(nb) * W - W)[:, None] + jnp.arange(2 * W)[None, :]
    valid = ((rel >= 0) & (rel < W))[None] & (kpos >= 0)[:, None, :]
    s = jnp.where(valid[None, :, None, None], s, -jnp.inf)
    sink = sinks.astype(jnp.float32).reshape(G, R)[None, None, :, :, None, None]
    m = jnp.maximum(jnp.max(s, axis=-1, keepdims=True), sink)
    p = jnp.exp(s - m)
    p = p / (jnp.sum(p, axis=-1, keepdims=True) + jnp.exp(sink - m))
    o = jnp.einsum('bngrqk,bnkgd->bnqgrd', p.astype(v.dtype), vb)
    return o.reshape(B, T, Hq * d)


def nsa_compress(a, pe, w1, w2):
    T = a.shape[1]
    nc = (T - NSA_CMP_LEN) // NSA_CMP_STRIDE + 1
    idx = jnp.arange(nc)[:, None] * NSA_CMP_STRIDE + jnp.arange(NSA_CMP_LEN)[None, :]
    blk = a[:, idx] + pe[None, None, :, None, :]
    hid = jax.nn.gelu(jnp.einsum('bnlgd,ldh->bngh', blk, w1))
    return jnp.einsum('bngh,he->bnge', hid, w2)


def nsa_attention(q, k_cmp, v_cmp, k_slc, v_slc, k_win, v_win, gates):
    B, T, H, d = q.shape
    G = k_slc.shape[2]
    R = H // G
    scale = d ** -0.5
    nc = k_cmp.shape[1]
    n_blk = T // NSA_SEL_LEN
    n_sel = min(NSA_N_SEL, n_blk)
    QB = NSA_Q_BLOCK
    W = NSA_WINDOW
    cmp_start = jnp.arange(nc) * NSA_CMP_STRIDE
    cmp_end = cmp_start + NSA_CMP_LEN - 1
    sel_start = jnp.arange(n_blk) * NSA_SEL_LEN
    overlap = ((cmp_start[:, None] < sel_start[None, :] + NSA_SEL_LEN)
               & (cmp_start[:, None] + NSA_CMP_LEN > sel_start[None, :])).astype(jnp.float32)
    k_sg = k_slc.transpose(0, 2, 1, 3)
    v_sg = v_slc.transpose(0, 2, 1, 3)
    k_wp = jnp.pad(k_win, ((0, 0), (W, 0), (0, 0), (0, 0)))
    v_wp = jnp.pad(v_win, ((0, 0), (W, 0), (0, 0), (0, 0)))
    gather = jax.vmap(jax.vmap(lambda a, idx: a[idx]))
    blk_ids = jnp.arange(n_blk)

    def query_block(start):
        t = start + jnp.arange(QB)
        qb = lax.dynamic_slice_in_dim(q, start, QB, axis=1).reshape(B, QB, G, R, d)
        gb = lax.dynamic_slice_in_dim(gates, start, QB, axis=1)
        s1 = jnp.einsum('bqgrd,bngd->bgrqn', qb, k_cmp, preferred_element_type=jnp.float32) * scale
        p1 = masked_softmax(s1, cmp_end[None, :] <= t[:, None])
        o_cmp = jnp.einsum('bgrqn,bngd->bqgrd', p1, v_cmp.astype(jnp.float32))
        imp = jnp.einsum('bgrqn,nj->bgqj', p1, overlap)
        cur = t // NSA_SEL_LEN
        forced = (blk_ids[None] == 0) | (blk_ids[None] == cur[:, None]) | (blk_ids[None] == cur[:, None] - 1)
        imp = jnp.where(blk_ids[None] > cur[:, None], -jnp.inf, imp)
        imp = jnp.where(forced, jnp.inf, imp)
        _, sel = lax.top_k(imp, n_sel)
        pos = (sel[..., None] * NSA_SEL_LEN + jnp.arange(NSA_SEL_LEN)).reshape(B, G, QB, n_sel * NSA_SEL_LEN)
        ks = gather(k_sg, pos)
        vs = gather(v_sg, pos)
        s2 = jnp.einsum('bqgrd,bgqpd->bgrqp', qb, ks, preferred_element_type=jnp.float32) * scale
        p2 = masked_softmax(s2, (pos <= t[None, None, :, None])[:, :, None])
        o_slc = jnp.einsum('bgrqp,bgqpd->bqgrd', p2, vs.astype(jnp.float32))
        kw = lax.dynamic_slice_in_dim(k_wp, start, W + QB, axis=1)
        vw = lax.dynamic_slice_in_dim(v_wp, start, W + QB, axis=1)
        kpos = start - W + jnp.arange(W + QB)
        rel = t[:, None] - kpos[None, :]
        s3 = jnp.einsum('bqgrd,bkgd->bgrqk', qb, kw, preferred_element_type=jnp.float32) * scale
        p3 = masked_softmax(s3, (rel >= 0) & (rel < W) & (kpos[None, :] >= 0))
        o_win = jnp.einsum('bgrqk,bkgd->bqgrd', p3, vw.astype(jnp.float32))
        g = jax.nn.sigmoid(gb.astype(jnp.float32)).reshape(B, QB, G, R, 3)
        o = g[..., 0:1] * o_cmp + g[..., 1:2] * o_slc + g[..., 2:3] * o_win
        return o.reshape(B, QB, H, d)

    out = lax.map(query_block, jnp.arange(T // QB, dtype=jnp.int32) * QB)
    return out.transpose(1, 0, 2, 3, 4).reshape(B, T, H * d)


def rotate(x, pos):
    half = x.shape[-1] // 2
    theta = 1.0 / (RET_THETA_BASE ** jnp.linspace(0.0, 1.0, half, dtype=jnp.float32))
    ang = pos.astype(jnp.float32)[:, None] * theta[None, :]
    cos = jnp.cos(ang)[None, :, None, :]
    sin = jnp.sin(ang)[None, :, None, :]
    x1, x2 = x[..., :half], x[..., half:]
    return jnp.concatenate([x1 * cos - x2 * sin, x2 * cos + x1 * sin], axis=-1)


def retention_chunkwise(q, k, v):
    B, T, H, dk = q.shape
    dv = v.shape[-1]
    C = RET_CHUNK
    N = T // C
    log_g = jnp.log1p(-jnp.exp2(-5.0 - jnp.arange(H, dtype=jnp.float32)))
    pos = jnp.arange(T)
    qc = rotate(q.astype(jnp.float32), pos).reshape(B, N, C, H, dk)
    kc = (rotate(k.astype(jnp.float32), pos) * (dk ** -0.5)).reshape(B, N, C, H, dk)
    vc = v.astype(jnp.float32).reshape(B, N, C, H, dv)
    j = jnp.arange(C, dtype=jnp.float32)
    diff = j[:, None] - j[None, :]
    dmat = jnp.where(diff >= 0, jnp.exp(jnp.maximum(diff, 0.0)[None] * log_g[:, None, None]), 0.0)
    inner = jnp.einsum('bnqhd,bnkhd->bnhqk', qc, kc) * dmat[None, None]
    o_inner = jnp.einsum('bnhqk,bnkhe->bnqhe', inner, vc)
    zeta = jnp.exp((C - 1 - j)[:, None] * log_g[None, :])
    kv = jnp.einsum('bnkhd,bnkhe->nbhde', kc * zeta[:, :, None], vc)
    chunk_decay = jnp.exp(C * log_g)[None, :, None, None]

    def step(state, kv_n):
        return chunk_decay * state + kv_n, state

    _, r_prev = lax.scan(step, jnp.zeros((B, H, dk, dv), jnp.float32), kv)
    xi = jnp.exp((j + 1.0)[:, None] * log_g[None, :])
    o_cross = jnp.einsum('bnqhd,nbhde->bnqhe', qc * xi[:, :, None], r_prev)
    return (o_inner + o_cross).reshape(B, T, H, dv)


def mixer_ab(h, w_in, w_out, lb, hg_norm, sw_sinks):
    B, T, _ = h.shape
    hq, hf, hi, hg, sq, sk, sv = split_cols(h @ w_in, AB_SIZES)
    o_a = hgrn2_recurrence(hq.reshape(B, T, HG_HEADS, HG_DK), hf.reshape(B, T, HG_HEADS, HG_DK),
                           hi.reshape(B, T, HG_HEADS, HG_DV), lb.reshape(HG_HEADS, HG_DK))
    o_a = head_rmsnorm(o_a, hg_norm) * jax.nn.silu(hg.astype(jnp.float32))
    o_b = sliding_window_sink_attention(sq.reshape(B, T, SW_HEADS, SW_DH), sk.reshape(B, T, SW_KV_HEADS, SW_DH),
                                        sv.reshape(B, T, SW_KV_HEADS, SW_DH), sw_sinks)
    return jnp.concatenate([o_a.astype(h.dtype), o_b.astype(h.dtype)], axis=-1) @ w_out


def mixer_cd(h, w_in, w_out, pe_k, w1_k, w2_k, pe_v, w1_v, w2_v, ret_norm):
    B, T, _ = h.shape
    nq, nkc, nvc, nks, nvs, nkw, nvw, ngt, rq, rk, rv, rg = split_cols(h @ w_in, CD_SIZES)
    G = NSA_KV_HEADS
    kv_heads = lambda a: a.reshape(B, T, G, NSA_DH)
    k_cmp = nsa_compress(kv_heads(nkc), pe_k, w1_k, w2_k)
    v_cmp = nsa_compress(kv_heads(nvc), pe_v, w1_v, w2_v)
    o_c = nsa_attention(nq.reshape(B, T, NSA_HEADS, NSA_DH), k_cmp, v_cmp, kv_heads(nks), kv_heads(nvs),
                        kv_heads(nkw), kv_heads(nvw), ngt.reshape(B, T, NSA_HEADS, 3))
    o_d = retention_chunkwise(rq.reshape(B, T, RET_HEADS, RET_DK), rk.reshape(B, T, RET_HEADS, RET_DK),
                              rv.reshape(B, T, RET_HEADS, RET_DV))
    o_d = head_layernorm(o_d, ret_norm) * jax.nn.silu(rg.astype(jnp.float32))
    return jnp.concatenate([o_c.astype(h.dtype), o_d.astype(h.dtype)], axis=-1) @ w_out


def routed_experts(xf, expert, gate, w_gate, w_up, w_down):
    N, K = expert.shape
    E = w_gate.shape[0]
    D = xf.shape[1]
    BLK = MOE_ROW_BLOCK
    A = N * K
    flat_e = expert.reshape(A)
    order = jnp.argsort(flat_e)
    e_sorted = flat_e[order]
    counts = jnp.bincount(flat_e, length=E)
    padded = (counts + BLK - 1) // BLK * BLK
    pad_end = jnp.cumsum(padded)
    pad_start = pad_end - padded
    start = jnp.cumsum(counts) - counts
    dest = pad_start[e_sorted] + jnp.arange(A) - start[e_sorted]
    rows = A + E * BLK
    n_blocks = rows // BLK
    row_tok = jnp.zeros((rows,), jnp.int32).at[dest].set((order // K).astype(jnp.int32))
    row_gate = jnp.zeros((rows,), jnp.float32).at[dest].set(gate.reshape(A)[order].astype(jnp.float32))
    blk_expert = jnp.minimum(jnp.searchsorted(pad_end, jnp.arange(n_blocks) * BLK, side='right'), E - 1)
    xs = xf[row_tok].reshape(n_blocks, BLK, D)

    def expert_block(args):
        xb, e = args
        hb = jax.nn.silu(xb @ w_gate[e]) * (xb @ w_up[e])
        return hb @ w_down[e]

    ys = lax.map(expert_block, (xs, blk_expert)).reshape(rows, D)
    out = jnp.zeros((N, D), jnp.float32).at[row_tok].add(ys.astype(jnp.float32) * row_gate[:, None])
    return out.astype(xf.dtype)


def hier_moe(x, w_grp, b_grp, w_exp, b_exp, w_gate, w_up, w_down):
    B, T, D = x.shape
    N = B * T
    xf = x.reshape(N, D)
    grp_logits = jnp.einsum('nd,dg->ng', xf, w_grp, preferred_element_type=jnp.float32) + b_grp.astype(jnp.float32)
    grp_prob = jax.nn.softmax(grp_logits, axis=-1)
    g_idx = jnp.argmax(grp_logits, axis=-1)
    p_grp = jnp.take_along_axis(grp_prob, g_idx[:, None], axis=1)[:, 0]
    exp_logits = (jnp.einsum('nd,de->ne', xf, w_exp, preferred_element_type=jnp.float32)
                  + b_exp.astype(jnp.float32)).reshape(N, MOE_GROUPS, MOE_EXPERTS_PER_GROUP)
    within = jnp.take_along_axis(exp_logits, g_idx[:, None, None], axis=1)[:, 0]
    top_p, top_i = lax.top_k(jax.nn.softmax(within, axis=-1), MOE_TOPK)
    gate = p_grp[:, None] * top_p / jnp.sum(top_p, axis=-1, keepdims=True)
    expert = (g_idx[:, None] * MOE_EXPERTS_PER_GROUP + top_i).astype(jnp.int32)
    return routed_experts(xf, expert, gate, w_gate, w_up, w_down).reshape(B, T, D)


def setup_inputs(seed: int = 0) -> dict:
    key = jax.random.key(seed)
    keys = iter(jax.random.split(key, 32))

    def normal(shape, scale):
        return jax.random.normal(next(keys), shape, jnp.float32) * scale

    n_even = (DEPTH + 1) // 2
    n_odd = DEPTH // 2
    D = D_MODEL
    return {
        "x": normal((BATCH, SEQ, D), 1.0),
        "norm_mix": 1.0 + normal((DEPTH, D), 0.05),
        "norm_ffn": 1.0 + normal((DEPTH, D), 0.05),
        "norm_final": 1.0 + normal((D,), 0.05),
        "ab_w_in": normal((n_even, D, sum(AB_SIZES)), D ** -0.5),
        "ab_w_out": normal((n_even, AB_OUT, D), AB_OUT ** -0.5),
        "hg_lb_logits": normal((DEPTH + 1, HG_HEADS * HG_DK), 0.5),
        "hg_norm": 1.0 + normal((n_even, HG_HEADS * HG_DV), 0.05),
        "sw_sinks": normal((n_even, SW_HEADS), 0.5),
        "cd_w_in": normal((n_odd, D, sum(CD_SIZES)), D ** -0.5),
        "cd_w_out": normal((n_odd, CD_OUT, D), CD_OUT ** -0.5),
        "nsa_pe_k": normal((n_odd, NSA_CMP_LEN, NSA_DH), 0.1),
        "nsa_w1_k": normal((n_odd, NSA_CMP_LEN, NSA_DH, NSA_CMP_HIDDEN), (NSA_CMP_LEN * NSA_DH) ** -0.5),
        "nsa_w2_k": normal((n_odd, NSA_CMP_HIDDEN, NSA_DH), NSA_CMP_HIDDEN ** -0.5),
        "nsa_pe_v": normal((n_odd, NSA_CMP_LEN, NSA_DH), 0.1),
        "nsa_w1_v": normal((n_odd, NSA_CMP_LEN, NSA_DH, NSA_CMP_HIDDEN), (NSA_CMP_LEN * NSA_DH) ** -0.5),
        "nsa_w2_v": normal((n_odd, NSA_CMP_HIDDEN, NSA_DH), NSA_CMP_HIDDEN ** -0.5),
        "ret_norm": 1.0 + normal((n_odd, RET_HEADS * RET_DV), 0.05),
        "moe_w_grp": normal((DEPTH, D, MOE_GROUPS), D ** -0.5),
        "moe_b_grp": normal((DEPTH, MOE_GROUPS), 0.01),
        "moe_w_exp": normal((DEPTH, D, MOE_EXPERTS), D ** -0.5),
        "moe_b_exp": normal((DEPTH, MOE_EXPERTS), 0.01),
        "moe_w_gate": normal((DEPTH, MOE_EXPERTS, D, MOE_DFF), D ** -0.5),
        "moe_w_up": normal((DEPTH, MOE_EXPERTS, D, MOE_DFF), D ** -0.5),
        "moe_w_down": normal((DEPTH, MOE_EXPERTS, MOE_DFF, D), MOE_DFF ** -0.5),
    }


def reference(x, norm_mix, norm_ffn, norm_final, ab_w_in, ab_w_out, hg_lb_logits, hg_norm, sw_sinks,
              cd_w_in, cd_w_out, nsa_pe_k, nsa_w1_k, nsa_w2_k, nsa_pe_v, nsa_w1_v, nsa_w2_v, ret_norm,
              moe_w_grp, moe_b_grp, moe_w_exp, moe_b_exp, moe_w_gate, moe_w_up, moe_w_down):
    lb_all = jnp.cumsum(jax.nn.softmax(hg_lb_logits.astype(jnp.float32), axis=0), axis=0)
    h = x
    for layer in range(DEPTH):
        hn = rmsnorm(h, norm_mix[layer])
        if layer % 2 == 0:
            e = layer // 2
            h = h + mixer_ab(hn, ab_w_in[e], ab_w_out[e], lb_all[layer], hg_norm[e], sw_sinks[e])
        else:
            o = layer // 2
            h = h + mixer_cd(hn, cd_w_in[o], cd_w_out[o], nsa_pe_k[o], nsa_w1_k[o], nsa_w2_k[o],
                             nsa_pe_v[o], nsa_w1_v[o], nsa_w2_v[o], ret_norm[o])
        hn = rmsnorm(h, norm_ffn[layer])
        h = h + hier_moe(hn, moe_w_grp[layer], moe_b_grp[layer], moe_w_exp[layer], moe_b_exp[layer],
                         moe_w_gate[layer], moe_w_up[layer], moe_w_down[layer])
    return rmsnorm(h, norm_final)
```

```cpp
#include <hip/hip_runtime.h>
#include <cstdio>
#include <cstdint>
#define IN0_BF_COLS 2560

#define XB_TMO      128
#define XB_XCNT(j)  (256  + 64 * (j))
#define XB_XSUB(j)  (1280 + 64 * (j))
#define XB_XGEN(j)  (2304 + 64 * (j))
#define XB_TOP      3328
#define XB_TOPGEN   3392
#define XCD_BAR_WORDS 3456
#define XB_SPIN_CAP (1u << 18)
#define LAS __attribute__((address_space(3)))

__device__ __forceinline__ unsigned xb_ld(unsigned* p)              { return __hip_atomic_load(p, __ATOMIC_RELAXED, __HIP_MEMORY_SCOPE_AGENT); }
__device__ __forceinline__ unsigned xb_add(unsigned* p, unsigned v) { return __hip_atomic_fetch_add(p, v, __ATOMIC_RELAXED, __HIP_MEMORY_SCOPE_AGENT); }
__device__ __forceinline__ unsigned xb_xcc_id() { return (unsigned)__builtin_amdgcn_s_getreg((3 << 11) | 20) & 0xFu; }
#define XB_SPIN(cond, bar) do { unsigned _sp = 0; while (cond) { __builtin_amdgcn_s_sleep(1); \
    if ((++_sp & 255u) == 0u) { if (xb_ld(&(bar)[XB_TMO])) break; if (_sp > XB_SPIN_CAP) { atomicAdd(&(bar)[XB_TMO], 1u); break; } } } } while (0)

struct XcdBarrier {
    unsigned* bar; unsigned x;
    volatile LAS unsigned* st;
};

__device__ __forceinline__ XcdBarrier xcd_barrier_post(unsigned* bar, volatile LAS unsigned* st) {
    XcdBarrier b; b.bar = bar; b.x = xb_xcc_id(); b.st = st;
    if (threadIdx.x == 0) (void)xb_add(&bar[XB_XCNT(b.x)], 1u);
    return b;
}
__device__ __forceinline__ void xcd_barrier_complete(unsigned* bar, unsigned x, unsigned& nloc, unsigned& nx) {
    const unsigned G = gridDim.x * gridDim.y * gridDim.z;
    unsigned sum, cnt, mine, sp = 0u;
    for (;;) {
        sum = 0u; cnt = 0u; mine = 0u;
#pragma unroll
        for (unsigned j = 0; j < 16; ++j) { const unsigned c = xb_ld(&bar[XB_XCNT(j)]); sum += c; cnt += (c > 0u) ? 1u : 0u; mine = (j == x) ? c : mine; }
        if (sum == G) break;
        __builtin_amdgcn_s_sleep(1);
        if ((++sp & 255u) == 0u) { if (xb_ld(&bar[XB_TMO])) break; if (sp > XB_SPIN_CAP) { atomicAdd(&bar[XB_TMO], 1u); break; } }
    }
    nloc = mine > 0u ? mine : 1u; nx = cnt > 0u ? cnt : 1u;
}

__device__ __forceinline__ void xcd_barrier(const XcdBarrier& b) {
    asm volatile("s_waitcnt vmcnt(0)" ::: "memory");
    __syncthreads();
    if (threadIdx.x == 0) {
        unsigned* bar = b.bar;
        __builtin_amdgcn_s_waitcnt(0);
        unsigned nloc = b.st[0], nx = b.st[1];
        if (nloc == 0u) { xcd_barrier_complete(bar, b.x, nloc, nx); b.st[0] = nloc; b.st[1] = nx; }
        const unsigned old = xb_add(&bar[XB_XSUB(b.x)], 1u);
        const unsigned gen = old / nloc;
        if (old + 1u == (gen + 1u) * nloc) {
            __builtin_amdgcn_fence(__ATOMIC_RELEASE, "agent");
            asm volatile("s_waitcnt vmcnt(0)" ::: "memory");
            const unsigned og = xb_add(&bar[XB_TOP], 1u);
            const unsigned tg = og / nx;
            if (og + 1u == (tg + 1u) * nx) xb_add(&bar[XB_TOPGEN], 1u);
            else XB_SPIN(xb_ld(&bar[XB_TOPGEN]) == tg, bar);
            __builtin_amdgcn_fence(__ATOMIC_ACQUIRE, "agent");
            xb_add(&bar[XB_XGEN(b.x)], 1u);
            asm volatile("s_waitcnt vmcnt(0)" ::: "memory");
        } else {
            XB_SPIN(xb_ld(&bar[XB_XGEN(b.x)]) == gen, bar);
            __builtin_amdgcn_fence(__ATOMIC_ACQUIRE, "agent");
            asm volatile("s_waitcnt vmcnt(0)" ::: "memory");
        }
    }
    __syncthreads();
}

namespace pg8 {
#define PG8_LAS __attribute__((address_space(3)))
typedef unsigned short bf16_t;
typedef short bf16x8 __attribute__((ext_vector_type(8)));
typedef float f32x4 __attribute__((ext_vector_type(4)));
typedef unsigned u32x4 __attribute__((ext_vector_type(4)));
constexpr int BM = 256, BK = 64, HALF = 128, HTB = HALF * BK * 2  , STAGE_BYTES = 8 * HTB, NXCD = 8, WGM = 8;

__host__ __device__ __forceinline__ int lds_byte(int r, int c) { const int st = (r >> 4) * 2 + (c >> 5), rr = r & 15, cc = c & 31, ob = rr * 64 + cc * 2; return st * 1024 + (ob ^ (((ob >> 9) & 1) << 5)); }
__host__ __device__ __forceinline__ void stage_rc(int b, int& R, int& C) { const int st = b / 1024, sb = b % 1024, swz = sb ^ (((sb >> 9) & 1) << 5); R = (st >> 1) * 16 + swz / 64; C = (st & 1) * 32 + (swz % 64) / 2; }
__host__ __device__ __forceinline__ int perm32(int rho) { const int n = rho >> 4, i = rho & 15; return 8 * (i >> 2) + 4 * n + (i & 3); }

struct Unit { int pm, pn; };
struct Gemm { const bf16_t* A; const bf16_t* Bt; int M, N, K; };

struct StaticOrder {
    int nM, nN, nwg, G, c;
    __host__ __device__ void init(int M, int N, int G_, int c_) { nM = M / BM; nN = N / BM; nwg = nM * nN; G = G_; c = c_; }
    __host__ __device__ bool next(int i, Unit& u) const {
        const long L = (long)i * G + c; if (L >= nwg) return false;
        int wgid = (int)L; { const int q = nwg / NXCD, r = nwg % NXCD, xcd = wgid % NXCD, off = wgid / NXCD; wgid = (xcd < r ? xcd * (q + 1) : r * (q + 1) + (xcd - r) * q) + off; }
        const int nig = WGM * nN, gid = wgid / nig, fm = gid * WGM, gsz = (nM - fm) < WGM ? (nM - fm) : WGM;
        u.pm = fm + ((wgid % nig) % gsz); u.pn = (wgid % nig) / gsz; return true;
    }
    __device__ __forceinline__ void a_ready(const Unit&) const {}
    __device__ __forceinline__ void done(const Unit&) const {}
};

typedef float f32x2c __attribute__((ext_vector_type(2))); typedef __bf16 bf16x2c __attribute__((ext_vector_type(2)));
__device__ __forceinline__ unsigned cvt_pk_bf16(float lo, float hi) { const f32x2c v = {lo, hi}; return __builtin_bit_cast(unsigned, __builtin_convertvector(v, bf16x2c)); }
typedef float f32x2 __attribute__((ext_vector_type(2)));
struct EpiBf16P {
    static constexpr bool PERM = true, AFTER_DRAIN = false;
    bf16_t* O; int ldc; float sc;
    __device__ __forceinline__ void operator()(const f32x4 (&acc)[2][2][4][2], const Unit& u, int wr, int wc, int fr, int fq) const {
        const int row0 = u.pm * BM + wr * 64 + fr, col0 = u.pn * BM + wc * 32 + 8 * fq;
#pragma unroll
        for (int ai = 0; ai < 2; ++ai)
#pragma unroll
            for (int m = 0; m < 4; ++m) { bf16_t* rowp = O + (size_t)(row0 + ai * HALF + m * 16) * ldc + col0;
#pragma unroll
                for (int bj = 0; bj < 2; ++bj) { const f32x4 v0 = acc[ai][bj][m][0] * sc, v1 = acc[ai][bj][m][1] * sc;
                    u32x4 w; w.x = cvt_pk_bf16(v0[0], v0[1]); w.y = cvt_pk_bf16(v0[2], v0[3]); w.z = cvt_pk_bf16(v1[0], v1[1]); w.w = cvt_pk_bf16(v1[2], v1[3]);
                    *(u32x4*)(rowp + bj * HALF) = w; } }
    }
};
struct EpiMoeDown {
    static constexpr bool PERM = true, AFTER_DRAIN = false;
    bf16_t* O; int ldc;
    __device__ __forceinline__ void operator()(const f32x4 (&acc)[2][2][4][2], const Unit& u, int wr, int wc, int fr, int fq) const {
        const int row0 = u.pm * BM + wr * 64 + fr, col0 = (u.pn & 7) * BM + wc * 32 + 8 * fq;
#pragma unroll
        for (int ai = 0; ai < 2; ++ai)
#pragma unroll
            for (int m = 0; m < 4; ++m) { bf16_t* rowp = O + (size_t)(row0 + ai * HALF + m * 16) * ldc + col0;
#pragma unroll
                for (int bj = 0; bj < 2; ++bj) { const f32x4 v0 = acc[ai][bj][m][0], v1 = acc[ai][bj][m][1];
                    u32x4 w; w.x = cvt_pk_bf16(v0[0], v0[1]); w.y = cvt_pk_bf16(v0[2], v0[3]); w.z = cvt_pk_bf16(v1[0], v1[1]); w.w = cvt_pk_bf16(v1[2], v1[3]);
                    *(u32x4*)(rowp + bj * HALF) = w; } }
    }
};
typedef unsigned u32x2 __attribute__((ext_vector_type(2)));
__device__ __forceinline__ unsigned pk_fp8x4(float a, float b, float c_, float d) { int r = 0; r = __builtin_amdgcn_cvt_pk_fp8_f32(a, b, r, false); r = __builtin_amdgcn_cvt_pk_fp8_f32(c_, d, r, true); return (unsigned)r; }
struct EpiSwiGLU8 {
    static constexpr bool PERM = true, AFTER_DRAIN = false;
    unsigned char* O;
    __device__ __forceinline__ void operator()(const f32x4 (&acc)[2][2][4][2], const Unit& u, int wr, int wc, int fr, int fq) const {
        const int row0 = u.pm * BM + wr * 64 + fr, col0 = (u.pn & 7) * 128 + wc * 32 + 8 * fq;
#pragma unroll
        for (int ai = 0; ai < 2; ++ai)
#pragma unroll
            for (int m = 0; m < 4; ++m) { unsigned char* rowp = O + (size_t)(row0 + ai * HALF + m * 16) * 1024 + col0;
                float h[8];
#pragma unroll
                for (int n = 0; n < 2; ++n)
#pragma unroll
                    for (int j = 0; j < 4; ++j) { const float g = acc[ai][0][m][n][j] * 0.03125f, up = acc[ai][1][m][n][j] * 0.03125f; h[n * 4 + j] = g * __builtin_amdgcn_rcpf(1.0f + __expf(-g)) * up; }
                u32x2 w; w.x = pk_fp8x4(8.f * h[0], 8.f * h[1], 8.f * h[2], 8.f * h[3]); w.y = pk_fp8x4(8.f * h[4], 8.f * h[5], 8.f * h[6], 8.f * h[7]);
                *(u32x2*)rowp = w; }
    }
};
struct EpiMoeDown8 {
    static constexpr bool PERM = true, AFTER_DRAIN = false;
    bf16_t* O; int ldc;
    __device__ __forceinline__ void operator()(const f32x4 (&acc)[2][2][4][2], const Unit& u, int wr, int wc, int fr, int fq) const {
        const int row0 = u.pm * BM + wr * 64 + fr, col0 = (u.pn & 7) * BM + wc * 32 + 8 * fq;
#pragma unroll
        for (int ai = 0; ai < 2; ++ai)
#pragma unroll
            for (int m = 0; m < 4; ++m) { bf16_t* rowp = O + (size_t)(row0 + ai * HALF + m * 16) * ldc + col0;
#pragma unroll
                for (int bj = 0; bj < 2; ++bj) { const f32x4 v0 = acc[ai][bj][m][0] * (0.03125f / 8.0f), v1 = acc[ai][bj][m][1] * (0.03125f / 8.0f);
                    u32x4 w; w.x = cvt_pk_bf16(v0[0], v0[1]); w.y = cvt_pk_bf16(v0[2], v0[3]); w.z = cvt_pk_bf16(v1[0], v1[1]); w.w = cvt_pk_bf16(v1[2], v1[3]);
                    *(u32x4*)(rowp + bj * HALF) = w; } }
    }
};
struct EpiMoeDown88 {
    static constexpr bool PERM = true, AFTER_DRAIN = false;
    unsigned char* O; int ldc;
    __device__ __forceinline__ void operator()(const f32x4 (&acc)[2][2][4][2], const Unit& u, int wr, int wc, int fr, int fq) const {
        const int row0 = u.pm * BM + wr * 64 + fr, col0 = (u.pn & 7) * BM + wc * 32 + 8 * fq;
#pragma unroll
        for (int ai = 0; ai < 2; ++ai)
#pragma unroll
            for (int m = 0; m < 4; ++m) { unsigned char* rowp = O + (size_t)(row0 + ai * HALF + m * 16) * ldc + col0;
#pragma unroll
                for (int bj = 0; bj < 2; ++bj) { const f32x4 v0 = acc[ai][bj][m][0] * 0.0625f, v1 = acc[ai][bj][m][1] * 0.0625f;
                    u32x2 w; w.x = pk_fp8x4(v0[0], v0[1], v0[2], v0[3]); w.y = pk_fp8x4(v1[0], v1[1], v1[2], v1[3]);
                    *(u32x2*)(rowp + bj * HALF) = w; } }
    }
};
struct EpiSwiGLU {
    static constexpr bool PERM = true, AFTER_DRAIN = false;
    bf16_t* O;
    __device__ __forceinline__ void operator()(const f32x4 (&acc)[2][2][4][2], const Unit& u, int wr, int wc, int fr, int fq) const {
        const int row0 = u.pm * BM + wr * 64 + fr, col0 = (u.pn & 7) * 128 + wc * 32 + 8 * fq;
#pragma unroll
        for (int ai = 0; ai < 2; ++ai)
#pragma unroll
            for (int m = 0; m < 4; ++m) { bf16_t* rowp = O + (size_t)(row0 + ai * HALF + m * 16) * 1024 + col0;
                float h[8];
#pragma unroll
                for (int n = 0; n < 2; ++n)
#pragma unroll
                    for (int j = 0; j < 4; ++j) { const float g = acc[ai][0][m][n][j], up = acc[ai][1][m][n][j]; h[n * 4 + j] = g * __builtin_amdgcn_rcpf(1.0f + __expf(-g)) * up; }
                u32x4 w; w.x = cvt_pk_bf16(h[0], h[1]); w.y = cvt_pk_bf16(h[2], h[3]); w.z = cvt_pk_bf16(h[4], h[5]); w.w = cvt_pk_bf16(h[6], h[7]);
                *(u32x4*)rowp = w; }
    }
};
struct EpiResF32 {
    static constexpr bool PERM = false, AFTER_DRAIN = false;
    const float* R; float* C; int ldc; float sc;
    __device__ __forceinline__ void operator()(const f32x4 (&acc)[2][2][4][2], const Unit& u, int wr, int wc, int fr, int fq) const {
        const int row0 = u.pm * BM + wr * 64 + fr, col0 = u.pn * BM + wc * 32 + 4 * fq;
#pragma unroll
        for (int ai = 0; ai < 2; ++ai)
#pragma unroll
            for (int m = 0; m < 4; ++m) { const size_t ro = (size_t)(row0 + ai * HALF + m * 16) * ldc + col0; f32x4 r[2][2];
#pragma unroll
                for (int bj = 0; bj < 2; ++bj)
#pragma unroll
                    for (int n = 0; n < 2; ++n) r[bj][n] = *(const f32x4*)(R + ro + bj * HALF + n * 16);
#pragma unroll
                for (int bj = 0; bj < 2; ++bj)
#pragma unroll
                    for (int n = 0; n < 2; ++n) *(f32x4*)(C + ro + bj * HALF + n * 16) = acc[ai][bj][m][n] * sc + r[bj][n]; }
    }
};
template <bool RF32> struct EpiResBf16 {
    static constexpr bool PERM = true, AFTER_DRAIN = false;
    const void* R; bf16_t* C; int ldc; float sc;
    __device__ __forceinline__ void operator()(const f32x4 (&acc)[2][2][4][2], const Unit& u, int wr, int wc, int fr, int fq) const {
        const int row0 = u.pm * BM + wr * 64 + fr, col0 = u.pn * BM + wc * 32 + 8 * fq;
#pragma unroll
        for (int ai = 0; ai < 2; ++ai) {
            f32x4 rf[4][2][2]; u32x4 rb[4][2];
#pragma unroll
            for (int m = 0; m < 4; ++m) { const size_t ro = (size_t)(row0 + ai * HALF + m * 16) * ldc + col0;
#pragma unroll
                for (int bj = 0; bj < 2; ++bj) {
                    if (RF32) { rf[m][bj][0] = __builtin_nontemporal_load((const f32x4*)((const float*)R + ro + bj * HALF)); rf[m][bj][1] = __builtin_nontemporal_load((const f32x4*)((const float*)R + ro + bj * HALF + 4)); }
                    else rb[m][bj] = *(const u32x4*)((const bf16_t*)R + ro + bj * HALF); } }
#pragma unroll
            for (int m = 0; m < 4; ++m) { const size_t ro = (size_t)(row0 + ai * HALF + m * 16) * ldc + col0;
#pragma unroll
                for (int bj = 0; bj < 2; ++bj) { f32x4 r0, r1;
                    if (RF32) { r0 = rf[m][bj][0]; r1 = rf[m][bj][1]; }
                    else { const u32x4 b = rb[m][bj];
                        r0 = (f32x4){__builtin_bit_cast(float, b.x << 16), __builtin_bit_cast(float, b.x & 0xffff0000u), __builtin_bit_cast(float, b.y << 16), __builtin_bit_cast(float, b.y & 0xffff0000u)};
                        r1 = (f32x4){__builtin_bit_cast(float, b.z << 16), __builtin_bit_cast(float, b.z & 0xffff0000u), __builtin_bit_cast(float, b.w << 16), __builtin_bit_cast(float, b.w & 0xffff0000u)}; }
                    const f32x4 v0 = acc[ai][bj][m][0] * sc + r0, v1 = acc[ai][bj][m][1] * sc + r1;
                    u32x4 w; w.x = cvt_pk_bf16(v0[0], v0[1]); w.y = cvt_pk_bf16(v0[2], v0[3]); w.z = cvt_pk_bf16(v1[0], v1[1]); w.w = cvt_pk_bf16(v1[2], v1[3]);
                    *(u32x4*)(C + ro + bj * HALF) = w; } } }
    }
};
struct EpiF32P {
    static constexpr bool PERM = false, AFTER_DRAIN = false;
    float* C; int ldc;
    __device__ __forceinline__ void operator()(const f32x4 (&acc)[2][2][4][2], const Unit& u, int wr, int wc, int fr, int fq) const {
        const int row0 = u.pm * BM + wr * 64 + fr, col0 = u.pn * BM + wc * 32 + 4 * fq;
#pragma unroll
        for (int ai = 0; ai < 2; ++ai)
#pragma unroll
            for (int m = 0; m < 4; ++m) { const size_t ro = (size_t)(row0 + ai * HALF + m * 16) * ldc + col0;
#pragma unroll
                for (int bj = 0; bj < 2; ++bj)
#pragma unroll
                    for (int n = 0; n < 2; ++n) *(f32x4*)(C + ro + bj * HALF + n * 16) = acc[ai][bj][m][n]; }
    }
};
struct MoeOrder : StaticOrder {
    const int* tile_exp;
    __device__ void initm(int RT, int G_, int c_, const int* te) { nM = RT; nN = 8; nwg = nM * nN; G = G_; c = c_; tile_exp = te; }
    __device__ bool next(int i, Unit& u) const {
        if (!StaticOrder::next(i, u)) return false;
        const int e = __builtin_amdgcn_readfirstlane(tile_exp[u.pm]);
        u.pn = e * 8 + u.pn; return true;
    }
};
template <class Epi, class Sched, bool ALIGN_EPI = false, bool SP2 = false, bool GATHER = false, bool FP8 = false>
__device__ __forceinline__ void gemm_phase(PG8_LAS unsigned char* lds, const Gemm g, const Sched& S, const Epi& E, const int* rowmap = nullptr) {
    const int tid = threadIdx.x, wid = __builtin_amdgcn_readfirstlane(tid >> 6), lane = tid & 63, wr = wid >> 2, wc = wid & 3, fr = lane & 15, fq = lane >> 4;
    const int K = g.K, Kb = FP8 ? K : 2 * K  , nt = Kb / (2 * BK);
    unsigned voffA[2], voffB[2];
#pragma unroll
    for (int i = 0; i < 2; ++i) { int R, C; stage_rc(tid * 16 + i * 8192, R, C); const int Rb = Epi::PERM ? ((R & ~31) + perm32(R & 31)) : R;
        voffA[i] = (unsigned)(R * Kb + C * 2); voffB[i] = (unsigned)(Rb * Kb + C * 2); }
    unsigned gc0[2], gc1[2], gn0[2], gn1[2]; int gR[2], gC[2];
    if constexpr (GATHER) {
#pragma unroll
        for (int i = 0; i < 2; ++i) { stage_rc(tid * 16 + i * 8192, gR[i], gC[i]); gc0[i] = gc1[i] = gn0[i] = gn1[i] = 0u; }
    }
#define PG8_GOFF(pm_, o0, o1) do { _Pragma("unroll") for (int _i = 0; _i < 2; ++_i) { \
        o0[_i] = (unsigned)rowmap[(pm_) * BM + gR[_i]] * (unsigned)Kb + (unsigned)(gC[_i] * 2); o1[_i] = (unsigned)rowmap[(pm_) * BM + HALF + gR[_i]] * (unsigned)Kb + (unsigned)(gC[_i] * 2); } } while (0)
    const size_t kstep = (size_t)(BK * 2);
    const size_t hstep = (size_t)HALF * Kb;
    const size_t tstep = 2 * hstep;
    const unsigned ldsw = (unsigned)wid * 1024u;
    const int aoff = lds_byte(wr * 64 + fr, fq * 8), boff = lds_byte(wc * 32 + fr, fq * 8);
#define PG8_SA(b, h) (((b) * 2 + (h)) * HTB)
#define PG8_SB(b, h) ((4 + (b) * 2 + (h)) * HTB)
#define PG8_STAGE(bufoff, gbase, voff) do { _Pragma("unroll") for (int _i = 0; _i < 2; ++_i) \
        __builtin_amdgcn_global_load_lds((const unsigned*)((const char*)(gbase) + (voff)[_i]), (PG8_LAS unsigned*)(lds + (bufoff) + ldsw + _i * 8192), 16, 0, 0); } while (0)
#define PG8_STAGE_A(bufoff, gbase, half, usenext) do { if constexpr (GATHER) { _Pragma("unroll") for (int _i = 0; _i < 2; ++_i) { const unsigned _o = (usenext) ? ((half) ? gn1[_i] : gn0[_i]) : ((half) ? gc1[_i] : gc0[_i]); \
        __builtin_amdgcn_global_load_lds((const unsigned*)((const char*)(gbase) + _o), (PG8_LAS unsigned*)(lds + (bufoff) + ldsw + _i * 8192), 16, 0, 0); } } else { PG8_STAGE(bufoff, (gbase) + ((half) ? hstep : 0), voffA); } } while (0)
#define PG8_V4(p) (*(const PG8_LAS v4i_*)(p))
#define PG8_LDA(dst, b, h) do { if constexpr (FP8) { _Pragma("unroll") for (int m = 0; m < 4; ++m) dst##8[m] = __builtin_shufflevector(PG8_V4(lds + PG8_SA(b, h) + aoff + m * 2048), PG8_V4(lds + PG8_SA(b, h) + aoff + m * 2048 + 1024), 0, 1, 2, 3, 4, 5, 6, 7); } \
    else { _Pragma("unroll") for (int m = 0; m < 4; ++m) _Pragma("unroll") for (int k = 0; k < 2; ++k) dst[m][k] = *(const PG8_LAS bf16x8*)(lds + PG8_SA(b, h) + aoff + m * 2048 + k * 1024); } } while (0)
#define PG8_LDB(dst, b, h) do { if constexpr (FP8) { _Pragma("unroll") for (int n = 0; n < 2; ++n) dst##8[n] = __builtin_shufflevector(PG8_V4(lds + PG8_SB(b, h) + boff + n * 2048), PG8_V4(lds + PG8_SB(b, h) + boff + n * 2048 + 1024), 0, 1, 2, 3, 4, 5, 6, 7); } \
    else { _Pragma("unroll") for (int n = 0; n < 2; ++n) _Pragma("unroll") for (int k = 0; k < 2; ++k) dst[n][k] = *(const PG8_LAS bf16x8*)(lds + PG8_SB(b, h) + boff + n * 2048 + k * 1024); } } while (0)
#define PG8_MMA(ai, bj, At, Bt) do { __builtin_amdgcn_s_setprio(1); _Pragma("unroll") for (int m = 0; m < 4; ++m) _Pragma("unroll") for (int n = 0; n < 2; ++n) { \
        if constexpr (FP8) { asm volatile("v_mfma_scale_f32_16x16x128_f8f6f4 %0, %1, %2, %0, %3, %3 op_sel_hi:[0,0,0]" : "+v"(acc[ai][bj][m][n]) : "v"(Bt##8[n]), "v"(At##8[m]), "v"(mxs)); }   \
        else { _Pragma("unroll") for (int k = 0; k < 2; ++k) acc[ai][bj][m][n] = __builtin_amdgcn_mfma_f32_16x16x32_bf16(Bt[n][k], At[m][k], acc[ai][bj][m][n], 0, 0, 0); } } \
        __builtin_amdgcn_s_setprio(0); } while (0)
#define PG8_WAIT_V(n) asm volatile("s_waitcnt vmcnt(" #n ")" ::: "memory")
#define PG8_WAIT_L(n) asm volatile("s_waitcnt lgkmcnt(" #n ")" ::: "memory")
#define PG8_BAR __builtin_amdgcn_s_barrier()
#define PG8_SCHED __builtin_amdgcn_sched_barrier(0)
    Unit cur, nxt; int ui = 0;
    if (!S.next(0, cur)) return;
    f32x4 acc[2][2][4][2];
#pragma unroll
    for (int a = 0; a < 2; ++a)
#pragma unroll
        for (int b = 0; b < 2; ++b)
#pragma unroll
            for (int m = 0; m < 4; ++m)
#pragma unroll
                for (int n = 0; n < 2; ++n) acc[a][b][m][n] = (f32x4){0.f, 0.f, 0.f, 0.f};
    typedef int v4i_ __attribute__((ext_vector_type(4))); typedef int v8i_ __attribute__((ext_vector_type(8)));
    const int mxs = 0x7f7f7f7f;
    bf16x8 At[4][2], B0[2][2], B1[2][2]; v8i_ At8[4], B08[2], B18[2];
    const char* cA = (const char*)g.A + (GATHER ? (size_t)0 : (size_t)cur.pm * tstep); const char* cB = (const char*)g.Bt + (size_t)cur.pn * tstep;
    if constexpr (GATHER) { PG8_GOFF(cur.pm, gc0, gc1); }
    S.a_ready(cur);
    if constexpr (SP2) {
        PG8_STAGE(PG8_SB(0, 0), cB, voffB); PG8_STAGE(PG8_SB(0, 1), cB + hstep, voffB); PG8_STAGE_A(PG8_SA(0, 0), cA, 0, false); PG8_STAGE_A(PG8_SA(0, 1), cA, 1, false);
        if (wr == 1) PG8_BAR;
        PG8_WAIT_V(2); PG8_BAR;
        PG8_STAGE(PG8_SB(1, 0), cB + kstep, voffB); PG8_STAGE_A(PG8_SA(1, 0), cA + kstep, 0, false); PG8_STAGE(PG8_SB(1, 1), cB + hstep + kstep, voffB);
        PG8_WAIT_V(6); PG8_BAR;
    } else {
        PG8_STAGE(PG8_SB(0, 0), cB, voffB); PG8_STAGE(PG8_SA(0, 0), cA, voffA); PG8_STAGE(PG8_SB(0, 1), cB + hstep, voffB); PG8_STAGE(PG8_SA(0, 1), cA + hstep, voffA);
        if (wr == 1) PG8_BAR;
        PG8_WAIT_V(4); PG8_BAR;
        PG8_STAGE(PG8_SB(1, 0), cB + kstep, voffB); PG8_STAGE(PG8_SA(1, 0), cA + kstep, voffA); PG8_STAGE(PG8_SB(1, 1), cB + hstep + kstep, voffB);
        PG8_WAIT_V(6); PG8_BAR;
    }
    for (;;) {
        const bool has_next = S.next(ui + 1, nxt);
        const char* nA = (has_next && !GATHER) ? (const char*)g.A + (size_t)nxt.pm * tstep : (GATHER ? (const char*)g.A : cA);
        if constexpr (GATHER) { if (has_next) { PG8_GOFF(nxt.pm, gn0, gn1); } else { gn0[0] = gc0[0]; gn0[1] = gc0[1]; gn1[0] = gc1[0]; gn1[1] = gc1[1]; } } const char* nB = has_next ? (const char*)g.Bt + (size_t)nxt.pn * tstep : cB;
        for (int t = 0; t < nt; t += 2) {
            const bool last = (t == nt - 2);
            const char* a1 = cA + (size_t)(t + 1) * kstep;
            const char* a2 = last ? nA : cA + (size_t)(t + 2) * kstep; const char* b2 = last ? nB : cB + (size_t)(t + 2) * kstep;
            const char* a3 = a2 + kstep; const char* b3 = b2 + kstep;
            if (last && has_next) S.a_ready(nxt);
            if constexpr (SP2) {
            PG8_LDB(B0, 0, 0); PG8_LDB(B1, 0, 1); PG8_SCHED; PG8_LDA(At, 0, 0); PG8_STAGE_A(PG8_SA(1, 1), a1, 1, false);
            PG8_WAIT_V(8); PG8_WAIT_L(0); PG8_BAR; PG8_MMA(0, 0, At, B0); PG8_MMA(0, 1, At, B1); PG8_BAR; PG8_SCHED;
            PG8_LDA(At, 0, 1); PG8_STAGE(PG8_SB(0, 0), b2, voffB); PG8_STAGE(PG8_SB(0, 1), b2 + hstep, voffB); PG8_STAGE_A(PG8_SA(0, 0), a2, 0, last);
            PG8_WAIT_V(8); PG8_WAIT_L(0); PG8_BAR; PG8_MMA(1, 0, At, B0); PG8_MMA(1, 1, At, B1); PG8_BAR; PG8_SCHED;
            PG8_LDB(B0, 1, 0); PG8_LDB(B1, 1, 1); PG8_SCHED; PG8_LDA(At, 1, 0); PG8_STAGE_A(PG8_SA(0, 1), a2, 1, last);
            PG8_WAIT_V(8); PG8_WAIT_L(0); PG8_BAR; PG8_MMA(0, 0, At, B0); PG8_MMA(0, 1, At, B1); PG8_BAR; PG8_SCHED;
            PG8_LDA(At, 1, 1); PG8_STAGE(PG8_SB(1, 0), b3, voffB); PG8_STAGE(PG8_SB(1, 1), b3 + hstep, voffB); PG8_STAGE_A(PG8_SA(1, 0), a3, 0, last);
            PG8_WAIT_V(8); PG8_WAIT_L(0); PG8_BAR; PG8_MMA(1, 0, At, B0); PG8_MMA(1, 1, At, B1); PG8_BAR; PG8_SCHED;
            } else {
            PG8_LDB(B0, 0, 0); PG8_SCHED; PG8_LDA(At, 0, 0); PG8_STAGE(PG8_SA(1, 1), a1 + hstep, voffA);
            PG8_WAIT_L(8); PG8_BAR; PG8_WAIT_L(0); PG8_MMA(0, 0, At, B0); PG8_BAR; PG8_SCHED;
            PG8_LDB(B1, 0, 1); PG8_STAGE(PG8_SB(0, 0), b2, voffB);
            PG8_BAR; PG8_WAIT_L(0); PG8_MMA(0, 1, At, B1); PG8_BAR;
            PG8_LDA(At, 0, 1); PG8_STAGE(PG8_SA(0, 0), a2, voffA);
            PG8_BAR; PG8_WAIT_L(0); PG8_MMA(1, 0, At, B0); PG8_BAR; PG8_SCHED;
            PG8_STAGE(PG8_SB(0, 1), b2 + hstep, voffB);
            PG8_WAIT_V(6); PG8_BAR; PG8_MMA(1, 1, At, B1); PG8_BAR;
            PG8_LDB(B0, 1, 0); PG8_SCHED; PG8_LDA(At, 1, 0); PG8_STAGE(PG8_SA(0, 1), a2 + hstep, voffA);
            PG8_WAIT_L(8); PG8_BAR; PG8_WAIT_L(0); PG8_MMA(0, 0, At, B0); PG8_BAR; PG8_SCHED;
            PG8_LDB(B1, 1, 1); PG8_STAGE(PG8_SB(1, 0), b3, voffB);
            PG8_BAR; PG8_WAIT_L(0); PG8_MMA(0, 1, At, B1); PG8_BAR;
            PG8_LDA(At, 1, 1); PG8_STAGE(PG8_SA(1, 0), a3, voffA);
            PG8_BAR; PG8_WAIT_L(0); PG8_MMA(1, 0, At, B0); PG8_BAR; PG8_SCHED;
            PG8_STAGE(PG8_SB(1, 1), b3 + hstep, voffB);
            PG8_WAIT_V(6); PG8_BAR; PG8_MMA(1, 1, At, B1); PG8_BAR;
            }
        }
        if constexpr (FP8) { asm volatile("s_nop 15\n\ts_nop 15\n\ts_nop 15" ::: "memory"); }
        if constexpr (ALIGN_EPI) { if (wr == 0) PG8_BAR; }
        if constexpr (!Epi::AFTER_DRAIN) { E(acc, cur, wr, wc, fr, fq); S.done(cur); }
        if (!has_next) break;
#pragma unroll
        for (int a = 0; a < 2; ++a)
#pragma unroll
            for (int b = 0; b < 2; ++b)
#pragma unroll
                for (int m = 0; m < 4; ++m)
#pragma unroll
                    for (int n = 0; n < 2; ++n) acc[a][b][m][n] = (f32x4){0.f, 0.f, 0.f, 0.f};
        cur = nxt; cA = nA; cB = nB; ++ui;
        if constexpr (GATHER) { gc0[0] = gn0[0]; gc0[1] = gn0[1]; gc1[0] = gn1[0]; gc1[1] = gn1[1]; }
        if constexpr (ALIGN_EPI) { if (wr == 1) PG8_BAR; }
    }
    PG8_WAIT_V(0);
    if constexpr (!ALIGN_EPI) { if (wr == 0) PG8_BAR; }
    PG8_BAR;
    if constexpr (Epi::AFTER_DRAIN) { E.fused(acc, cur, wr, wc, fr, fq, lds, wid, lane); S.done(cur); }
#undef PG8_SA
#undef PG8_SB
#undef PG8_STAGE
#undef PG8_STAGE_A
#undef PG8_GOFF
#undef PG8_LDA
#undef PG8_V4
#undef PG8_LDB
#undef PG8_MMA
#undef PG8_WAIT_V
#undef PG8_WAIT_L
#undef PG8_BAR
#undef PG8_SCHED
}
}
using pg8::bf16_t; using pg8::bf16x8; using pg8::f32x4; using pg8::u32x4; using pg8::cvt_pk_bf16; using pg8::pk_fp8x4;
typedef short s16x4 __attribute__((ext_vector_type(4)));
using pg8::u32x2;
#ifndef MOE_FP8_ON
#define MOE_FP8_ON 1
#endif
#ifndef IN_FP8_ON
#define IN_FP8_ON 0
#endif
#ifndef OUT_FP8_ON
#define OUT_FP8_ON 1
#endif
#ifndef IN1_FP8_ON
#define IN1_FP8_ON 1
#endif
constexpr bool IN_FP8 = (IN_FP8_ON != 0), OUT_FP8 = (OUT_FP8_ON != 0), IN1_FP8 = (IN1_FP8_ON != 0) || IN_FP8;
constexpr bool MOE_FP8 = (MOE_FP8_ON != 0);
#ifndef CVT_OVERLAP_WG
#define CVT_OVERLAP_WG 0
#endif
constexpr int CVT_WG = CVT_OVERLAP_WG;
#define PROBE_CAT_(a, b) a##b
#ifndef PROBE_HS1
#define PROBE_HS1 1
#endif
#ifndef PROBE_SWA
#define PROBE_SWA 1
#endif
#ifndef PROBE_HSC
#define PROBE_HSC 1
#endif
#ifndef PROBE_HS3
#define PROBE_HS3 1
#endif
#ifndef PROBE_CMP
#define PROBE_CMP 1
#endif
#ifndef PROBE_RS1
#define PROBE_RS1 1
#endif
#ifndef PROBE_RSC
#define PROBE_RSC 1
#endif
#ifndef PROBE_NSA
#define PROBE_NSA 1
#endif
#ifndef PROBE_RS3
#define PROBE_RS3 1
#endif
#ifndef PROBE_G10
#define PROBE_G10 1
#endif
#ifndef PROBE_G11
#define PROBE_G11 1
#endif
#ifndef PROBE_P0
#define PROBE_P0 1
#endif
#ifndef PROBE_C12
#define PROBE_C12 1
#endif
#ifndef IN0_BF_COLS
#define IN0_BF_COLS 3072
#endif
#ifndef PROBE_G17
#define PROBE_G17 1
#endif
#ifndef PROBE_NSA_SKIP
#define PROBE_NSA_SKIP 0
#endif
#ifndef PROBE_SEL
#define PROBE_SEL 1
#endif
#ifndef PROBE_B2
#define PROBE_B2 1
#endif
#ifndef PROBE_B3
#define PROBE_B3 1
#endif
#ifndef PROBE_NR
#define PROBE_NR 1
#endif
#ifndef PROBE_CMB
#define PROBE_CMB 1
#endif
#ifndef PROBE_G5
#define PROBE_G5 1
#endif
#ifndef PROBE_G13
#define PROBE_G13 1
#endif
#define PROBE_REP(name) PROBE_CAT_(PROBE_, name)
constexpr int NTHR = 512, NWAVE = 8;
constexpr int DM = 2048, NBATCH = 8, SEQ = 4096, MTOK = NBATCH * SEQ;
constexpr int IN0_BF = IN0_BF_COLS;
constexpr int NAB = 5632, NCD = 5888, LDP = 5888;
constexpr int C_HQ = 0, C_HF = 1024, C_HI = 2048, C_HG = 3072, C_SQ = 4096, C_SK = 5120, C_SV = 5376;
constexpr int C_NQ = 0, C_NKC = 1024, C_NVC = 1280, C_NKS = 1536, C_NVS = 1792, C_NKW = 2048, C_NVW = 2304, C_RQ = 2560, C_RK = 3072, C_RV = 3584, C_RG = 4608, C_GT = 5632;
constexpr int NEXP = 32, DFF = 1024, MOE_MAXROWS = 73728, MOE_MAXTILES = 288;
constexpr float RMS_EPS = 1e-6f, LOG2E = 1.4426950408889634f;
constexpr int LDS_BYTES = 163840;
constexpr size_t al256(size_t x) { return (x + 255) & ~(size_t)255; }
constexpr size_t WS_CTL = 0, CTL_BYTES = 65536;
constexpr int CW_CNT = 4096, CW_CUR = 4096 + 64, CW_RT = 4096 + 128;
constexpr size_t WS_WAB_IN = WS_CTL + CTL_BYTES;
constexpr size_t WS_WAB_OUT = WS_WAB_IN + (size_t)NAB * DM * 2;
constexpr size_t WS_WCD_IN = WS_WAB_OUT + (size_t)DM * DM * 2;
constexpr size_t WS_WCD_OUT = WS_WCD_IN + (size_t)NCD * DM * 2;
constexpr size_t WS_WRT = WS_WCD_OUT + (size_t)DM * DM * 2;
constexpr size_t WS_W1 = WS_WRT + (size_t)2 * 256 * DM * 2;
constexpr size_t WS_W2 = WS_W1 + (size_t)NEXP * 2048 * DM * 2;
constexpr size_t WS_NW1 = WS_W2 + (size_t)NEXP * DM * DFF * 2;
constexpr size_t WS_NW2 = WS_NW1 + (size_t)2 * 128 * 4096 * 2;
constexpr size_t WS_NBIAS = WS_NW2 + (size_t)2 * 128 * 128 * 2;
constexpr size_t WS_LB = WS_NBIAS + 16384;
constexpr size_t WS_HN = al256(WS_LB + 4096);
constexpr size_t WS_PROJ = WS_HN + (size_t)MTOK * DM * 2;
constexpr size_t WS_MIX = WS_PROJ + (size_t)MTOK * LDP * 2;
constexpr size_t WS_LOG = WS_MIX + (size_t)MTOK * DM * 2;
constexpr size_t WS_RTE = WS_LOG + (size_t)MTOK * 256 * 4;
constexpr size_t WS_TEXP = WS_RTE + (size_t)MTOK * 2 * 4 * 3;
constexpr size_t WS_ROWTOK = al256(WS_TEXP + 4096);
constexpr size_t WS_KCMP = al256(WS_ROWTOK + (size_t)MOE_MAXROWS * 4);
constexpr size_t WS_R = al256(WS_KCMP + (size_t)2 * 8 * 2 * 256 * 128 * 2);
constexpr size_t WS_XS = WS_R, WS_HID = WS_XS + (size_t)MOE_MAXROWS * DM * 2;
constexpr size_t WS_DS = WS_R, WS_SPREV = WS_DS + (size_t)4096 * 16384 * 4, WS_DEC = WS_SPREV + (size_t)4096 * 16384 * 2;
constexpr size_t WS_END0 = WS_HID + (size_t)MOE_MAXROWS * DFF * 2;
constexpr size_t WS_KV = WS_END0, WS_RPREV = WS_KV + (size_t)1024 * 32768 * 4;
constexpr size_t WS_HN8 = WS_RPREV + (size_t)1024 * 32768 * 2;
constexpr size_t WS_MIX8 = WS_HN8 + (size_t)MTOK * DM;
constexpr size_t WS_END = WS_MIX8 + (size_t)MTOK * DM;
static_assert(WS_DEC + (size_t)4096 * 128 * 4 <= WS_END0, "aliased region");
static_assert(WS_END <= ((size_t)1 << 31), "workspace must fit 2 GiB");

#define LAS __attribute__((address_space(3)))
typedef LAS unsigned char* ldsp;
__device__ __forceinline__ float bf2f(bf16_t b) { return __uint_as_float(((unsigned)b) << 16); }
__device__ __forceinline__ float bflo(unsigned w) { return __uint_as_float(w << 16); }
__device__ __forceinline__ float bfhi(unsigned w) { return __uint_as_float(w & 0xffff0000u); }
__device__ __forceinline__ bf16_t f2bf(float f) { return (bf16_t)(cvt_pk_bf16(f, 0.f) & 0xffffu); }
constexpr float ACT8_SCALE = 8.0f, ACT8_DESCALE = 0.03125f / 8.0f;
__device__ __forceinline__ unsigned char f2fp8(float f) { return (unsigned char)(__builtin_amdgcn_cvt_pk_fp8_f32(f, 0.f, 0, false) & 0xff); }
__device__ __forceinline__ unsigned pk2(float lo, float hi) { return cvt_pk_bf16(lo, hi); }
__device__ __forceinline__ f32x4 mfma16(bf16x8 a, bf16x8 b, f32x4 c) { return __builtin_amdgcn_mfma_f32_16x16x32_bf16(a, b, c, 0, 0, 0); }
__device__ __forceinline__ float sigmoidf_(float x) { return __builtin_amdgcn_rcpf(1.0f + __expf(-x)); }
__device__ __forceinline__ float wave_sum(float v) { for (int o = 32; o >= 1; o >>= 1) v += __shfl_xor(v, o); return v; }
template <int N> __device__ __forceinline__ float dpp_ror(float v) { return __builtin_bit_cast(float, __builtin_amdgcn_update_dpp(0, __builtin_bit_cast(int, v), 0x120 + N, 0xF, 0xF, false)); }
__device__ __forceinline__ float grp16_sum(float v) { v += dpp_ror<8>(v); v += dpp_ror<4>(v); v += dpp_ror<2>(v); v += dpp_ror<1>(v); return v; }
__device__ __forceinline__ float grp16_max(float v) { v = fmaxf(v, dpp_ror<8>(v)); v = fmaxf(v, dpp_ror<4>(v)); v = fmaxf(v, dpp_ror<2>(v)); v = fmaxf(v, dpp_ror<1>(v)); return v; }
__device__ __forceinline__ unsigned lds_addr(ldsp p) { return (unsigned)(size_t)p; }
__device__ __forceinline__ unsigned tr_lane_off(int lane, int rs) { return (unsigned)((8 * (lane >> 4) + ((lane & 15) >> 2)) * rs + (lane & 3) * 8); }
__device__ __forceinline__ bf16x8 tr_frag(unsigned a, int rs) {
    s16x4 lo, hi; const unsigned a1 = a + 4 * rs;
    asm volatile("ds_read_b64_tr_b16 %0, %2\n\tds_read_b64_tr_b16 %1, %3\n\ts_waitcnt lgkmcnt(0)" : "=&v"(lo), "=&v"(hi) : "v"(a), "v"(a1) : "memory");
    bf16x8 r; r[0] = lo[0]; r[1] = lo[1]; r[2] = lo[2]; r[3] = lo[3]; r[4] = hi[0]; r[5] = hi[1]; r[6] = hi[2]; r[7] = hi[3]; return r;
}
__device__ __forceinline__ void tr_frag2(unsigned a, unsigned b, int rs, bf16x8& ra, bf16x8& rb) {
    s16x4 l0, h0, l1, h1; const unsigned a1 = a + 4 * rs, b1 = b + 4 * rs;
    asm volatile("ds_read_b64_tr_b16 %0, %4\n\tds_read_b64_tr_b16 %1, %5\n\tds_read_b64_tr_b16 %2, %6\n\tds_read_b64_tr_b16 %3, %7\n\ts_waitcnt lgkmcnt(0)"
                 : "=&v"(l0), "=&v"(h0), "=&v"(l1), "=&v"(h1) : "v"(a), "v"(a1), "v"(b), "v"(b1) : "memory");
    ra[0] = l0[0]; ra[1] = l0[1]; ra[2] = l0[2]; ra[3] = l0[3]; ra[4] = h0[0]; ra[5] = h0[1]; ra[6] = h0[2]; ra[7] = h0[3];
    rb[0] = l1[0]; rb[1] = l1[1]; rb[2] = l1[2]; rb[3] = l1[3]; rb[4] = h1[0]; rb[5] = h1[1]; rb[6] = h1[2]; rb[7] = h1[3];
}
__device__ __forceinline__ int opq(int x) { asm volatile("" : "+v"(x)); return x; }
#define LDS_FENCE() asm volatile("s_waitcnt lgkmcnt(0)" ::: "memory")

struct Frame {
    const float* in[25]; float* out; unsigned char* ws; ldsp lds;
    int tid, lane, wave, G, bid;
};
#define PHASE_FRAME(F0) Frame F = (F0); { int t_ = (F0).tid; asm volatile("" : "+v"(t_)); F.tid = t_; F.lane = t_ & 63; F.wave = __builtin_amdgcn_readfirstlane(t_ >> 6); }
template <int MODE> __device__ __forceinline__ float4 cvt_load(const float* s0, const float* s1, int ld, int k, int n, int nvalid) {
    const float* p = nullptr;
    if (MODE == 0) { if (n < nvalid) p = s0 + (size_t)k * ld + n; }
    else if (MODE == 1) { if (n < 2560) p = s0 + (size_t)k * ld + n; else if (n < 5632) p = s0 + (size_t)k * ld + n + 24; else if (n < 5656) p = s0 + (size_t)k * ld + (n - 5632 + 2560); }
    else if (MODE == 2) { const int idx = 128 * (n >> 8) + (n & 127); p = (((n >> 7) & 1) ? s1 : s0) + (size_t)k * ld + idx; }
    else { if (n < 4) p = s0 + (size_t)k * 4 + n; else if (n < 36) p = s1 + (size_t)k * 32 + (n - 4); }
    if (p) return *(const float4*)p;
    return make_float4(0.f, 0.f, 0.f, 0.f);
}
template <int MODE, bool OUT8 = false> __device__ __forceinline__ void cvt_job(const Frame& F, const float* s0, const float* s1, bf16_t* dst, int ld, int K, int nnt, int nvalid, int nbatch, size_t sb, size_t db, int& rr) {
    constexpr int RS = 272;
    const int nkt = (K + 127) / 128, nnt2 = 2 * nnt, per = nkt * nnt2, ntiles = per * nbatch;
    const int first = (F.bid - (rr % F.G) + F.G) % F.G;
    const int lr = F.lane >> 5, lc = 4 * (F.lane & 31);
    float4 v[8];
    auto load_tile = [&](int tile) { const int e = tile / per, t2 = tile - e * per, nt = t2 % nnt2, kt = t2 / nnt2;
        const float* a0 = s0 + (size_t)e * sb; const float* a1 = s1 ? s1 + (size_t)e * sb : nullptr;
#pragma unroll
        for (int r = 0; r < 8; ++r) { const int k = kt * 128 + F.wave * 16 + 2 * r + lr; v[r] = (k < K) ? cvt_load<MODE>(a0, a1, ld, k, nt * 128 + lc, nvalid) : make_float4(0.f, 0.f, 0.f, 0.f); } };
    int tile = first;
    if (tile < ntiles) load_tile(tile);
    while (tile < ntiles) {
        const int e = tile / per, t2 = tile - e * per, nt = t2 % nnt2, kt = t2 / nnt2;
#pragma unroll
        for (int r = 0; r < 8; ++r) { u32x2 w; w.x = pk2(v[r].x, v[r].y); w.y = pk2(v[r].z, v[r].w); *(LAS u32x2*)(F.lds + (F.wave * 16 + 2 * r + lr) * RS + 2 * lc) = w; }
        __syncthreads();
        const int next = tile + F.G;
        if (next < ntiles) load_tile(next);
        bf16_t* d = dst + (size_t)e * db;
        const unsigned tb = lds_addr(F.lds) + tr_lane_off(F.lane, RS) + 32 * F.wave;
        const int n = nt * 128 + 16 * F.wave + (F.lane & 15);
#pragma unroll
        for (int kb = 0; kb < 4; kb += 2) { bf16x8 f0, f1; tr_frag2(tb + 32 * kb * RS, tb + 32 * (kb + 1) * RS, RS, f0, f1);
            const int k0 = kt * 128 + 32 * kb + 8 * (F.lane >> 4);
            if constexpr (OUT8) {
                unsigned char* d8 = (unsigned char*)dst + (size_t)e * db;
                u32x2 w0, w1;
                w0.x = pk_fp8x4(32.f * bf2f((bf16_t)f0[0]), 32.f * bf2f((bf16_t)f0[1]), 32.f * bf2f((bf16_t)f0[2]), 32.f * bf2f((bf16_t)f0[3])); w0.y = pk_fp8x4(32.f * bf2f((bf16_t)f0[4]), 32.f * bf2f((bf16_t)f0[5]), 32.f * bf2f((bf16_t)f0[6]), 32.f * bf2f((bf16_t)f0[7]));
                w1.x = pk_fp8x4(32.f * bf2f((bf16_t)f1[0]), 32.f * bf2f((bf16_t)f1[1]), 32.f * bf2f((bf16_t)f1[2]), 32.f * bf2f((bf16_t)f1[3])); w1.y = pk_fp8x4(32.f * bf2f((bf16_t)f1[4]), 32.f * bf2f((bf16_t)f1[5]), 32.f * bf2f((bf16_t)f1[6]), 32.f * bf2f((bf16_t)f1[7]));
                if (n < nvalid && k0 < K) *(u32x2*)(d8 + (size_t)n * K + k0) = w0;
                if (n < nvalid && k0 + 32 < K) *(u32x2*)(d8 + (size_t)n * K + k0 + 32) = w1;
            } else {
            if (n < nvalid && k0 < K) *(bf16x8*)(d + (size_t)n * K + k0) = f0;
            if (n < nvalid && k0 + 32 < K) *(bf16x8*)(d + (size_t)n * K + k0 + 32) = f1; } }
        __syncthreads();
        tile = next;
    }
    rr += ntiles;
}
__device__ __forceinline__ void convert_moe_layer(const Frame& F, int layer, int& rr) {
    const size_t wsz = (size_t)NEXP * DM * DFF;
    cvt_job<2, MOE_FP8>(F, F.in[22] + layer * wsz, F.in[23] + layer * wsz, (bf16_t*)(F.ws + WS_W1), DFF, DM, 8, 2048, NEXP, (size_t)DM * DFF, (size_t)2048 * DM, rr);
    cvt_job<0, MOE_FP8>(F, F.in[24] + layer * wsz, nullptr, (bf16_t*)(F.ws + WS_W2), DM, DFF, 8, 2048, NEXP, (size_t)DFF * DM, (size_t)DM * DFF, rr);
}
template <bool OUT8 = false> __device__ __forceinline__ void rmsnorm_rows(const Frame& F0, const float* src, const float* w, bf16_t* dst) { PHASE_FRAME(F0);
    for (int row = F.bid * NWAVE + F.wave; row < MTOK; row += F.G * NWAVE) {
        const float4* p = (const float4*)(src + (size_t)row * DM); float4 v[8]; float ss = 0.f;
#pragma unroll
        for (int i = 0; i < 8; ++i) { v[i] = p[F.lane + 64 * i]; ss += v[i].x * v[i].x + v[i].y * v[i].y + v[i].z * v[i].z + v[i].w * v[i].w; }
        ss = wave_sum(ss); const float rstd = rsqrtf(ss * (1.0f / DM) + RMS_EPS);
#pragma unroll
        for (int i = 0; i < 8; ++i) { const float4 g = ((const float4*)w)[F.lane + 64 * i];
            if constexpr (OUT8) *(unsigned*)((unsigned char*)(F.ws + WS_HN8) + (size_t)row * DM + 4 * (F.lane + 64 * i)) = pk_fp8x4(v[i].x * rstd * g.x, v[i].y * rstd * g.y, v[i].z * rstd * g.z, v[i].w * rstd * g.w);
            { u32x2 o; o.x = pk2(v[i].x * rstd * g.x, v[i].y * rstd * g.y); o.y = pk2(v[i].z * rstd * g.z, v[i].w * rstd * g.w); *(u32x2*)(dst + (size_t)row * DM + 4 * (F.lane + 64 * i)) = o; } }
    }
}
__device__ __forceinline__ void p0_prologue(const Frame& F0) { PHASE_FRAME(F0);
    int rr = 0;
    cvt_job<0, false>(F, F.in[4], nullptr, (bf16_t*)(F.ws + WS_WAB_IN), NAB, DM, IN0_BF / 256, IN0_BF, 1, 0, 0, rr);
    cvt_job<0, true>(F, F.in[4] + IN0_BF, nullptr, (bf16_t*)(F.ws + WS_WAB_IN + (size_t)IN0_BF * DM * 2), NAB, DM, (NAB - IN0_BF) / 256, NAB - IN0_BF, 1, 0, 0, rr);
    cvt_job<0, OUT_FP8>(F, F.in[5], nullptr, (bf16_t*)(F.ws + WS_WAB_OUT), DM, DM, 8, DM, 1, 0, 0, rr);
    cvt_job<1, IN1_FP8>(F, F.in[9], nullptr, (bf16_t*)(F.ws + WS_WCD_IN), 5656, DM, 23, NCD, 1, 0, 0, rr);
    cvt_job<0, OUT_FP8>(F, F.in[10], nullptr, (bf16_t*)(F.ws + WS_WCD_OUT), DM, DM, 8, DM, 1, 0, 0, rr);
    cvt_job<3>(F, F.in[18], F.in[20], (bf16_t*)(F.ws + WS_WRT), 0, DM, 1, 256, 1, 0, 0, rr);
    cvt_job<3>(F, F.in[18] + DM * 4, F.in[20] + DM * 32, (bf16_t*)(F.ws + WS_WRT) + 256 * DM, 0, DM, 1, 256, 1, 0, 0, rr);
    cvt_job<0>(F, F.in[12], nullptr, (bf16_t*)(F.ws + WS_NW1), 128, 4096, 1, 128, 1, 0, 0, rr);
    cvt_job<0>(F, F.in[15], nullptr, (bf16_t*)(F.ws + WS_NW1) + 128 * 4096, 128, 4096, 1, 128, 1, 0, 0, rr);
    cvt_job<0>(F, F.in[13], nullptr, (bf16_t*)(F.ws + WS_NW2), 128, 128, 1, 128, 1, 0, 0, rr);
    cvt_job<0>(F, F.in[16], nullptr, (bf16_t*)(F.ws + WS_NW2) + 128 * 128, 128, 128, 1, 128, 1, 0, 0, rr);
    if (CVT_WG == 0) convert_moe_layer(F, 0, rr);
    if (F.bid == 0) {
        const float* z = F.in[6];
        for (int c = F.tid; c < 1024; c += NTHR) { const float a = z[c], b = z[1024 + c], d = z[2048 + c], m = fmaxf(a, fmaxf(b, d)); const float ea = __expf(a - m), eb = __expf(b - m), ed = __expf(d - m);
            ((float*)(F.ws + WS_LB))[c] = ea / (ea + eb + ed); }
    }
    if (F.bid < 16) {
        const int h = F.tid & 127, part = F.tid >> 7;
        for (int kv = 0; kv < 2; ++kv) {
            const float* pe = F.in[kv ? 14 : 11]; const float* w1 = F.in[kv ? 15 : 12]; float s = 0.f;
#pragma unroll 8
            for (int k = F.bid * 256 + part * 64; k < F.bid * 256 + part * 64 + 64; ++k) s += pe[k] * w1[(size_t)k * 128 + h];
            __syncthreads();
            ((LAS float*)F.lds)[part * 128 + h] = s;
            __syncthreads();
            if (F.tid < 128) ((float*)(F.ws + WS_NBIAS))[(kv * 16 + F.bid) * 128 + F.tid] = (((LAS float*)F.lds)[F.tid] + ((LAS float*)F.lds)[128 + F.tid]) + (((LAS float*)F.lds)[256 + F.tid] + ((LAS float*)F.lds)[384 + F.tid]);
            __syncthreads();
        }
    }
    rmsnorm_rows<true>(F, F.in[0], F.in[1], (bf16_t*)(F.ws + WS_HN));
}
__device__ __forceinline__ void route_phase(const Frame& F0, int layer) { PHASE_FRAME(F0);
    const float* LG = (const float*)(F.ws + WS_LOG); const float* bg = F.in[19] + layer * 4; const float* be = F.in[21] + layer * 32;
    int* rexp = (int*)(F.ws + WS_RTE); float* rgate = (float*)(F.ws + WS_RTE + (size_t)MTOK * 8);
    unsigned* cnt = (unsigned*)(F.ws + WS_CTL) + CW_CNT + layer * 32;
    LAS unsigned* hist = (LAS unsigned*)F.lds;
    for (int i = F.bid * NTHR + F.tid; i < MOE_MAXROWS; i += F.G * NTHR) ((int*)(F.ws + WS_ROWTOK))[i] = 0;
    for (int ch = F.bid; ch < MTOK / 128; ch += F.G) {
        if (F.tid < 32) hist[F.tid] = 0u;
        __syncthreads();
        if (F.tid < 128) {
            const int tok = ch * 128 + F.tid; const float* l = LG + (size_t)tok * 256;
            float gl[4]; int gi = 0; float gm = -INFINITY;
#pragma unroll
            for (int i = 0; i < 4; ++i) { gl[i] = l[i] + bg[i]; if (gl[i] > gm) { gm = gl[i]; gi = i; } }
            float gs = 0.f;
#pragma unroll
            for (int i = 0; i < 4; ++i) gs += __expf(gl[i] - gm);
            const float pg = 1.0f / gs;
            float el[8]; float em = -INFINITY;
#pragma unroll
            for (int i = 0; i < 8; ++i) { el[i] = l[4 + gi * 8 + i] + be[gi * 8 + i]; em = fmaxf(em, el[i]); }
            int i0 = 0; float v0 = -INFINITY;
#pragma unroll
            for (int i = 0; i < 8; ++i) if (el[i] > v0) { v0 = el[i]; i0 = i; }
            int i1 = 0; float v1 = -INFINITY;
#pragma unroll
            for (int i = 0; i < 8; ++i) if (i != i0 && el[i] > v1) { v1 = el[i]; i1 = i; }
            const float p0 = __expf(v0 - em), p1 = __expf(v1 - em), inv = pg / (p0 + p1);
            const int e0 = gi * 8 + i0, e1 = gi * 8 + i1;
            rexp[tok * 2] = e0; rexp[tok * 2 + 1] = e1; rgate[tok * 2] = p0 * inv; rgate[tok * 2 + 1] = p1 * inv;
            __hip_atomic_fetch_add(&hist[e0], 1u, __ATOMIC_RELAXED, __HIP_MEMORY_SCOPE_WORKGROUP); __hip_atomic_fetch_add(&hist[e1], 1u, __ATOMIC_RELAXED, __HIP_MEMORY_SCOPE_WORKGROUP);
        }
        __syncthreads();
        if (F.tid < 32 && hist[F.tid]) __hip_atomic_fetch_add(cnt + F.tid, hist[F.tid], __ATOMIC_RELAXED, __HIP_MEMORY_SCOPE_AGENT);
        __syncthreads();
    }
}
constexpr int NR_TILE = 0, NR_PITCH = 4112, NR_PART = 16 * NR_PITCH, NR_LOGS = NR_PART + 8 * 16 * 48 * 4, NR_HIST = NR_LOGS + 16 * 48 * 4;
__device__ __forceinline__ void norm_route_phase(const Frame& F0, int layer, const float* w) { PHASE_FRAME(F0);
    const bf16_t* H = layer ? (const bf16_t*)(F.ws + WS_PROJ) : (const bf16_t*)F.out; bf16_t* HN = (bf16_t*)(F.ws + WS_HN); const float* bg = F.in[19] + layer * 4; const float* be = F.in[21] + layer * 32;
    int* rexp = (int*)(F.ws + WS_RTE); float* rgate = (float*)(F.ws + WS_RTE + (size_t)MTOK * 8);
    unsigned* cnt = (unsigned*)(F.ws + WS_CTL) + CW_CNT + layer * 32;
    LAS float* PART = (LAS float*)(F.lds + NR_PART); LAS float* LOGS = (LAS float*)(F.lds + NR_LOGS); LAS unsigned* hist = (LAS unsigned*)(F.lds + NR_HIST);
    const int c = F.lane & 15, g4 = F.lane >> 4;
    for (int i = F.bid * NTHR + F.tid; i < MOE_MAXROWS; i += F.G * NTHR) ((int*)(F.ws + WS_ROWTOK))[i] = 0;
    if (F.tid < 32) hist[F.tid] = 0u;
    bf16x8 bfr[3][8]; { const bf16_t* wr = (const bf16_t*)(F.ws + WS_WRT) + (size_t)layer * 256 * DM;
#pragma unroll
        for (int nb = 0; nb < 3; ++nb)
#pragma unroll
            for (int ks = 0; ks < 8; ++ks) bfr[nb][ks] = *(const bf16x8*)(wr + (size_t)(16 * nb + c) * DM + 256 * F.wave + 32 * ks + 8 * g4); }
    __syncthreads();
    for (int rep_ = 0; rep_ < PROBE_NR; ++rep_) { if (rep_) { __syncthreads(); if (F.tid < 32) hist[F.tid] = 0u; __syncthreads(); }
    for (int bt = F.bid; bt < MTOK / 16; bt += F.G) {
#pragma unroll 1
        for (int rr = 0; rr < 2; ++rr) { const int r = 2 * F.wave + rr; const size_t row = (size_t)bt * 16 + r;
            const u32x2* p = (const u32x2*)(H + row * DM); float4 v[8]; float ss = 0.f;
#pragma unroll
            for (int i = 0; i < 8; ++i) { const u32x2 hv = p[F.lane + 64 * i]; v[i].x = bflo(hv.x); v[i].y = bfhi(hv.x); v[i].z = bflo(hv.y); v[i].w = bfhi(hv.y); ss += v[i].x * v[i].x + v[i].y * v[i].y + v[i].z * v[i].z + v[i].w * v[i].w; }
            ss = wave_sum(ss); const float rstd = rsqrtf(ss * (1.0f / DM) + RMS_EPS);
#pragma unroll
            for (int i = 0; i < 8; ++i) { const float4 g = ((const float4*)w)[F.lane + 64 * i]; u32x2 o; o.x = pk2(v[i].x * rstd * g.x, v[i].y * rstd * g.y); o.y = pk2(v[i].z * rstd * g.z, v[i].w * rstd * g.w);
                if (!MOE_FP8) *(u32x2*)(HN + row * DM + 4 * (F.lane + 64 * i)) = o;
                *(LAS u32x2*)(F.lds + NR_TILE + r * NR_PITCH + 8 * (F.lane + 64 * i)) = o;
                if (MOE_FP8) *(unsigned*)((unsigned char*)(F.ws + WS_HN8) + row * DM + 4 * (F.lane + 64 * i)) = pk_fp8x4(v[i].x * rstd * g.x, v[i].y * rstd * g.y, v[i].z * rstd * g.z, v[i].w * rstd * g.w); } }
        __syncthreads();
        f32x4 acc[3] = {(f32x4){0.f, 0.f, 0.f, 0.f}, (f32x4){0.f, 0.f, 0.f, 0.f}, (f32x4){0.f, 0.f, 0.f, 0.f}};
#pragma unroll
        for (int ks = 0; ks < 8; ++ks) { const bf16x8 a = *(LAS bf16x8*)(F.lds + NR_TILE + c * NR_PITCH + (256 * F.wave + 32 * ks + 8 * g4) * 2);
#pragma unroll
            for (int nb = 0; nb < 3; ++nb) acc[nb] = mfma16(a, bfr[nb][ks], acc[nb]); }
#pragma unroll
        for (int nb = 0; nb < 3; ++nb)
#pragma unroll
            for (int j = 0; j < 4; ++j) PART[(F.wave * 16 + 4 * g4 + j) * 48 + 16 * nb + c] = acc[nb][j];
        __syncthreads();
        for (int idx = F.tid; idx < 16 * 48; idx += NTHR) { float s = 0.f;
#pragma unroll
            for (int ww = 0; ww < 8; ++ww) s += PART[ww * 768 + idx];
            LOGS[idx] = s; }
        __syncthreads();
        if (F.tid < 16) {
            const int tok = bt * 16 + F.tid; const LAS float* l = LOGS + F.tid * 48;
            float gl[4]; int gi = 0; float gm = -INFINITY;
#pragma unroll
            for (int i = 0; i < 4; ++i) { gl[i] = l[i] + bg[i]; if (gl[i] > gm) { gm = gl[i]; gi = i; } }
            float gs = 0.f;
#pragma unroll
            for (int i = 0; i < 4; ++i) gs += __expf(gl[i] - gm);
            const float pg = 1.0f / gs;
            float el[8]; float em = -INFINITY;
#pragma unroll
            for (int i = 0; i < 8; ++i) { el[i] = l[4 + gi * 8 + i] + be[gi * 8 + i]; em = fmaxf(em, el[i]); }
            int i0 = 0; float v0 = -INFINITY;
#pragma unroll
            for (int i = 0; i < 8; ++i) if (el[i] > v0) { v0 = el[i]; i0 = i; }
            int i1 = 0; float v1 = -INFINITY;
#pragma unroll
            for (int i = 0; i < 8; ++i) if (i != i0 && el[i] > v1) { v1 = el[i]; i1 = i; }
            const float p0 = __expf(v0 - em), p1 = __expf(v1 - em), inv = pg / (p0 + p1);
            const int e0 = gi * 8 + i0, e1 = gi * 8 + i1;
            rexp[tok * 2] = e0; rexp[tok * 2 + 1] = e1; rgate[tok * 2] = p0 * inv; rgate[tok * 2 + 1] = p1 * inv;
            __hip_atomic_fetch_add(&hist[e0], 1u, __ATOMIC_RELAXED, __HIP_MEMORY_SCOPE_WORKGROUP); __hip_atomic_fetch_add(&hist[e1], 1u, __ATOMIC_RELAXED, __HIP_MEMORY_SCOPE_WORKGROUP);
        }
        __syncthreads();
    } }
    if (F.tid < 32 && hist[F.tid]) __hip_atomic_fetch_add(cnt + F.tid, hist[F.tid], __ATOMIC_RELAXED, __HIP_MEMORY_SCOPE_AGENT);
    __syncthreads();
}
__device__ __forceinline__ void gather_phase(const Frame& F0, int layer) { PHASE_FRAME(F0);
    const int* rexp = (const int*)(F.ws + WS_RTE); int* rdest = (int*)(F.ws + WS_RTE + (size_t)MTOK * 16);
    unsigned* ctl = (unsigned*)(F.ws + WS_CTL); unsigned* cnt = ctl + CW_CNT + layer * 32; unsigned* cur = ctl + CW_CUR + layer * 32;
    int* texp = (int*)(F.ws + WS_TEXP); int* rowtok = (int*)(F.ws + WS_ROWTOK);
    LAS unsigned* L = (LAS unsigned*)F.lds;
    if (F.tid < 32) L[385 + F.tid] = ((cnt[F.tid] + 255u) >> 8) << 8;
    __syncthreads();
    if (F.tid == 0) { unsigned acc = 0; for (int e = 0; e < 32; ++e) { L[64 + e] = acc; acc += L[385 + e]; } L[384] = acc; }
    __syncthreads();
    if (F.bid == 0) {
        const unsigned total = L[384];
        if (F.tid == 0) ctl[CW_RT + layer] = total >> 8;
        for (int t = F.tid; t < (int)(total >> 8); t += NTHR) { int e = 0; for (int k = 1; k < 32; ++k) if (L[64 + k] <= (unsigned)t * 256u) e = k; texp[t] = e; }
    }
    for (int ch = F.bid; ch < MTOK / 128; ch += F.G) {
        if (F.tid < 32) { L[F.tid] = 0u; L[96 + F.tid] = 0u; }
        __syncthreads();
        int e0 = 0, e1 = 0;
        if (F.tid < 128) { const int tok = ch * 128 + F.tid; e0 = rexp[tok * 2]; e1 = rexp[tok * 2 + 1]; __hip_atomic_fetch_add(&L[e0], 1u, __ATOMIC_RELAXED, __HIP_MEMORY_SCOPE_WORKGROUP); __hip_atomic_fetch_add(&L[e1], 1u, __ATOMIC_RELAXED, __HIP_MEMORY_SCOPE_WORKGROUP); }
        __syncthreads();
        if (F.tid < 32) L[32 + F.tid] = L[F.tid] ? __hip_atomic_fetch_add(cur + F.tid, L[F.tid], __ATOMIC_RELAXED, __HIP_MEMORY_SCOPE_AGENT) : 0u;
        __syncthreads();
        if (F.tid < 128) { const int tok = ch * 128 + F.tid;
            const unsigned d0 = L[64 + e0] + L[32 + e0] + __hip_atomic_fetch_add(&L[96 + e0], 1u, __ATOMIC_RELAXED, __HIP_MEMORY_SCOPE_WORKGROUP);
            const unsigned d1 = L[64 + e1] + L[32 + e1] + __hip_atomic_fetch_add(&L[96 + e1], 1u, __ATOMIC_RELAXED, __HIP_MEMORY_SCOPE_WORKGROUP);
            rdest[tok * 2] = (int)d0; rdest[tok * 2 + 1] = (int)d1; rowtok[d0] = tok; rowtok[d1] = tok; }
        __syncthreads();
        __syncthreads();
    }
}
template <bool FINAL> __device__ __forceinline__ void combine_phase(const Frame& F0, const float* w) { PHASE_FRAME(F0);
    const float* rgate = (const float*)(F.ws + WS_RTE + (size_t)MTOK * 8); const int* rdest = (const int*)(F.ws + WS_RTE + (size_t)MTOK * 16);
    static_assert(MOE_FP8, "combine reads e4m3 expert outputs");
    const unsigned char* YS = (const unsigned char*)(F.ws + WS_XS); float* OUT = F.out; bf16_t* H = FINAL ? (bf16_t*)(F.ws + WS_PROJ) : (bf16_t*)F.out;
    float ng0 = 0.f, ng1 = 0.f; int nd0 = 0, nd1 = 0;
    { const int row = F.bid * NWAVE + F.wave; if (row < MTOK) { ng0 = rgate[row * 2]; ng1 = rgate[row * 2 + 1]; nd0 = rdest[row * 2]; nd1 = rdest[row * 2 + 1]; } }
    for (int row = F.bid * NWAVE + F.wave; row < MTOK; row += F.G * NWAVE) {
        const float g0 = ng0 * 0.0625f, g1 = ng1 * 0.0625f; const int d0 = nd0, d1 = nd1;
        { const int nrow = row + F.G * NWAVE; if (nrow < MTOK) { ng0 = rgate[nrow * 2]; ng1 = rgate[nrow * 2 + 1]; nd0 = rdest[nrow * 2]; nd1 = rdest[nrow * 2 + 1]; } }
        const u32x4* p = (const u32x4*)(H + (size_t)row * DM); const u32x2* y0 = (const u32x2*)(YS + (size_t)d0 * DM); const u32x2* y1 = (const u32x2*)(YS + (size_t)d1 * DM);
        float v[4][8]; float ss = 0.f;
        u32x4 hv[4]; u32x2 ya[4], yb[4];
#pragma unroll
        for (int i = 0; i < 4; ++i) { hv[i] = p[F.lane + 64 * i]; ya[i] = y0[F.lane + 64 * i]; yb[i] = y1[F.lane + 64 * i]; }
#pragma unroll
        for (int i = 0; i < 4; ++i) {
            const unsigned hw[4] = {hv[i].x, hv[i].y, hv[i].z, hv[i].w}; const unsigned aw[2] = {ya[i].x, ya[i].y}, bw[2] = {yb[i].x, yb[i].y};
#define CMB_PAIR(k, HI) do { const pg8::f32x2c a = __builtin_amdgcn_cvt_pk_f32_fp8((int)aw[(k) >> 1], HI), b = __builtin_amdgcn_cvt_pk_f32_fp8((int)bw[(k) >> 1], HI); \
                v[i][2 * (k)] = bflo(hw[k]) + g0 * a[0] + g1 * b[0]; v[i][2 * (k) + 1] = bfhi(hw[k]) + g0 * a[1] + g1 * b[1]; \
                ss += v[i][2 * (k)] * v[i][2 * (k)] + v[i][2 * (k) + 1] * v[i][2 * (k) + 1]; } while (0)
            CMB_PAIR(0, false); CMB_PAIR(1, true); CMB_PAIR(2, false); CMB_PAIR(3, true);
#undef CMB_PAIR
        }
        ss = wave_sum(ss); const float rstd = rsqrtf(ss * (1.0f / DM) + RMS_EPS);
#pragma unroll
        for (int i = 0; i < 4; ++i) { const float4 ga = ((const float4*)w)[2 * (F.lane + 64 * i)], gb = ((const float4*)w)[2 * (F.lane + 64 * i) + 1];
            const float n[8] = {v[i][0] * rstd * ga.x, v[i][1] * rstd * ga.y, v[i][2] * rstd * ga.z, v[i][3] * rstd * ga.w, v[i][4] * rstd * gb.x, v[i][5] * rstd * gb.y, v[i][6] * rstd * gb.z, v[i][7] * rstd * gb.w};
            if (FINAL) { float4* op = (float4*)(OUT + (size_t)row * DM) + 2 * (F.lane + 64 * i); op[0] = make_float4(n[0], n[1], n[2], n[3]); op[1] = make_float4(n[4], n[5], n[6], n[7]); }
            else { u32x4 hw; hw.x = pk2(v[i][0], v[i][1]); hw.y = pk2(v[i][2], v[i][3]); hw.z = pk2(v[i][4], v[i][5]); hw.w = pk2(v[i][6], v[i][7]); ((u32x4*)(H + (size_t)row * DM))[F.lane + 64 * i] = hw;
                static_assert(IN1_FP8, "layer-1 input projection reads e4m3 activations");
                u32x2 o8; o8.x = pk_fp8x4(n[0], n[1], n[2], n[3]); o8.y = pk_fp8x4(n[4], n[5], n[6], n[7]); ((u32x2*)((unsigned char*)(F.ws + WS_HN8) + (size_t)row * DM))[F.lane + 64 * i] = o8; } }
    }
}
constexpr int KT_PITCH = 272, PW_PITCH = 144, TILE_B = 64 * KT_PITCH;
constexpr int AL_KT0 = 0, AL_VT0 = TILE_B, AL_KT1 = 2 * TILE_B, AL_VT1 = 3 * TILE_B, AL_PW = 4 * TILE_B, AL_PWW = 16 * PW_PITCH, AL_Q = AL_PW + NWAVE * AL_PWW, AL_END = AL_Q + 128 * KT_PITCH;
struct TileRegs { u32x4 k[2], v[2]; };
__device__ __forceinline__ void stage_tile(const Frame& F, ldsp dst, const bf16_t* src_row0, int ld, int pos0, int lim) {
#pragma unroll
    for (int i = 0; i < 2; ++i) { const int id = F.tid + NTHR * i, r = id >> 4, ch = id & 15; const int pos = pos0 + r;
        u32x4 v = (u32x4){0u, 0u, 0u, 0u};
        if (pos >= 0 && pos < lim) v = *(const u32x4*)(src_row0 + (unsigned)(r * ld + ch * 8));
        *(LAS u32x4*)(dst + r * KT_PITCH + ch * 16) = v; }
}
template <bool WK, bool WV> __device__ __forceinline__ void tile_prefetch(const Frame& F, const bf16_t* ksrc, const bf16_t* vsrc, int ld, int pos0, int lim, TileRegs& R) {
#pragma unroll
    for (int i = 0; i < 2; ++i) { const int id = F.tid + NTHR * i, r = id >> 4, ch = id & 15; const int pos = pos0 + r; const bool ok = (pos >= 0 && pos < lim);
        R.k[i] = (u32x4){0u, 0u, 0u, 0u}; R.v[i] = (u32x4){0u, 0u, 0u, 0u};
        if (WK && ok) R.k[i] = *(const u32x4*)(ksrc + (unsigned)(r * ld + ch * 8));
        if (WV && ok) R.v[i] = *(const u32x4*)(vsrc + (unsigned)(r * ld + ch * 8)); }
}
template <bool WK, bool WV> __device__ __forceinline__ void tile_commit(const Frame& F, ldsp KT, ldsp VT, const TileRegs& R) {
#pragma unroll
    for (int i = 0; i < 2; ++i) { const int id = F.tid + NTHR * i, r = id >> 4, ch = id & 15;
        if (WK) *(LAS u32x4*)(KT + r * KT_PITCH + ch * 16) = R.k[i];
        if (WV) *(LAS u32x4*)(VT + r * KT_PITCH + ch * 16) = R.v[i]; }
}
__device__ __forceinline__ void tr_frag4(unsigned a, unsigned b, unsigned c_, unsigned d, int rs, bf16x8& ra, bf16x8& rb, bf16x8& rc, bf16x8& rd) {
    s16x4 l0, h0, l1, h1, l2, h2, l3, h3; const unsigned a1 = a + 4 * rs, b1 = b + 4 * rs, c1 = c_ + 4 * rs, d1 = d + 4 * rs;
    asm volatile("ds_read_b64_tr_b16 %0, %8\n\tds_read_b64_tr_b16 %1, %9\n\tds_read_b64_tr_b16 %2, %10\n\tds_read_b64_tr_b16 %3, %11\n\t"
                 "ds_read_b64_tr_b16 %4, %12\n\tds_read_b64_tr_b16 %5, %13\n\tds_read_b64_tr_b16 %6, %14\n\tds_read_b64_tr_b16 %7, %15\n\ts_waitcnt lgkmcnt(0)"
                 : "=&v"(l0), "=&v"(h0), "=&v"(l1), "=&v"(h1), "=&v"(l2), "=&v"(h2), "=&v"(l3), "=&v"(h3) : "v"(a), "v"(a1), "v"(b), "v"(b1), "v"(c_), "v"(c1), "v"(d), "v"(d1) : "memory");
    ra[0] = l0[0]; ra[1] = l0[1]; ra[2] = l0[2]; ra[3] = l0[3]; ra[4] = h0[0]; ra[5] = h0[1]; ra[6] = h0[2]; ra[7] = h0[3];
    rb[0] = l1[0]; rb[1] = l1[1]; rb[2] = l1[2]; rb[3] = l1[3]; rb[4] = h1[0]; rb[5] = h1[1]; rb[6] = h1[2]; rb[7] = h1[3];
    rc[0] = l2[0]; rc[1] = l2[1]; rc[2] = l2[2]; rc[3] = l2[3]; rc[4] = h2[0]; rc[5] = h2[1]; rc[6] = h2[2]; rc[7] = h2[3];
    rd[0] = l3[0]; rd[1] = l3[1]; rd[2] = l3[2]; rd[3] = l3[3]; rd[4] = h3[0]; rd[5] = h3[1]; rd[6] = h3[2]; rd[7] = h3[3];
}
__device__ __forceinline__ void stage_q(const Frame& F, const bf16_t* qbase) {
#pragma unroll
    for (int i = 0; i < 4; ++i) { const int id = F.tid + NTHR * i, row = id >> 4, ch = id & 15;
        *(LAS u32x4*)(F.lds + AL_Q + row * KT_PITCH + ch * 16) = *(const u32x4*)(qbase + (unsigned)((row >> 2) * LDP + (row & 3) * 128 + ch * 8)); }
}
__device__ __forceinline__ void mb_scores(const Frame& F, ldsp KT, f32x4 (&s)[4]) {
    const int c = F.lane & 15, kg = F.lane >> 4; bf16x8 qa[4];
#pragma unroll
    for (int ks = 0; ks < 4; ++ks) qa[ks] = *(LAS bf16x8*)(F.lds + AL_Q + (16 * F.wave + c) * KT_PITCH + (32 * ks + 8 * kg) * 2);
#pragma unroll
    for (int nb = 0; nb < 4; ++nb) { s[nb] = (f32x4){0.f, 0.f, 0.f, 0.f};
#pragma unroll
        for (int ks = 0; ks < 4; ++ks) { const bf16x8 kb = *(LAS bf16x8*)(KT + (16 * nb + c) * KT_PITCH + (32 * ks + 8 * kg) * 2); s[nb] = mfma16(qa[ks], kb, s[nb]); } }
}
__device__ __forceinline__ void tile_pv_lds(const Frame& F, ldsp VT, ldsp PWw, f32x4 (&o)[8]) {
    const int c = F.lane & 15, g4 = F.lane >> 4;
    LDS_FENCE();
    const unsigned vbase = lds_addr(VT) + tr_lane_off(F.lane, KT_PITCH);
#pragma unroll
    for (int ks = 0; ks < 2; ++ks) { const bf16x8 pa = *(LAS bf16x8*)(PWw + c * PW_PITCH + (32 * ks + 8 * g4) * 2);
#pragma unroll
        for (int ne = 0; ne < 8; ne += 2) { bf16x8 v0, v1; const unsigned vb = vbase + 32 * ks * KT_PITCH + 32 * ne; tr_frag2(vb, vb + 32, KT_PITCH, v0, v1);
            o[ne] = mfma16(pa, v0, o[ne]); o[ne + 1] = mfma16(pa, v1, o[ne + 1]); } }
    LDS_FENCE();
}
template <class MaskF> __device__ __forceinline__ void attn_tile(const Frame& F, ldsp KT, ldsp VT, ldsp PWw, f32x4 (&o)[8], float (&m)[4], float (&z)[4], float scale2, MaskF mask) {
    const int c = F.lane & 15, g4 = F.lane >> 4, q = 4 * F.wave + g4; f32x4 s[4]; mb_scores(F, KT, s);
    bool ok[4];
#pragma unroll
    for (int nb = 0; nb < 4; ++nb) ok[nb] = mask(q, 16 * nb + c);
#pragma unroll
    for (int j = 0; j < 4; ++j) { float mx = -INFINITY;
#pragma unroll
        for (int nb = 0; nb < 4; ++nb) { const float v = ok[nb] ? s[nb][j] * scale2 : -INFINITY; s[nb][j] = v; mx = fmaxf(mx, v); }
        mx = grp16_max(mx); const float mo = m[j], mn = fmaxf(mo, mx), mu = (mn == -INFINITY) ? 0.f : mn, al = __builtin_amdgcn_exp2f(mo - mu); float rs = 0.f;
#pragma unroll
        for (int nb = 0; nb < 4; ++nb) { const float p = __builtin_amdgcn_exp2f(s[nb][j] - mu); rs += p; s[nb][j] = p; }
        rs = grp16_sum(rs); z[j] = z[j] * al + rs; m[j] = mn;
#pragma unroll
        for (int ne = 0; ne < 8; ++ne) o[ne][j] *= al; }
#pragma unroll
    for (int nb = 0; nb < 4; ++nb) {
        const unsigned p01 = cvt_pk_bf16(s[nb][0], s[nb][1]), p23 = cvt_pk_bf16(s[nb][2], s[nb][3]);
        ldsp pw = PWw + (4 * g4) * PW_PITCH + (16 * nb + c) * 2;
        *(LAS bf16_t*)(pw) = (bf16_t)(p01 & 0xffffu); *(LAS bf16_t*)(pw + PW_PITCH) = (bf16_t)(p01 >> 16);
        *(LAS bf16_t*)(pw + 2 * PW_PITCH) = (bf16_t)(p23 & 0xffffu); *(LAS bf16_t*)(pw + 3 * PW_PITCH) = (bf16_t)(p23 >> 16); }
    tile_pv_lds(F, VT, PWw, o);
}
__device__ __forceinline__ float rowgrp_max(float v) { v = fmaxf(v, __shfl_xor(v, 16)); v = fmaxf(v, __shfl_xor(v, 32)); return v; }
__device__ __forceinline__ float rowgrp_sum(float v) { v += __shfl_xor(v, 16); v += __shfl_xor(v, 32); return v; }
__device__ __forceinline__ void tr_frag2s(unsigned a, unsigned b, int d1, bf16x8& ra, bf16x8& rb) {
    s16x4 l0, h0, l1, h1; const unsigned a1 = a + d1, b1 = b + d1;
    asm volatile("ds_read_b64_tr_b16 %0, %4\n\tds_read_b64_tr_b16 %1, %5\n\tds_read_b64_tr_b16 %2, %6\n\tds_read_b64_tr_b16 %3, %7\n\ts_waitcnt lgkmcnt(0)"
                 : "=&v"(l0), "=&v"(h0), "=&v"(l1), "=&v"(h1) : "v"(a), "v"(a1), "v"(b), "v"(b1) : "memory");
    ra[0] = l0[0]; ra[1] = l0[1]; ra[2] = l0[2]; ra[3] = l0[3]; ra[4] = h0[0]; ra[5] = h0[1]; ra[6] = h0[2]; ra[7] = h0[3];
    rb[0] = l1[0]; rb[1] = l1[1]; rb[2] = l1[2]; rb[3] = l1[3]; rb[4] = h1[0]; rb[5] = h1[1]; rb[6] = h1[2]; rb[7] = h1[3];
}
template <class MaskF> __device__ __forceinline__ void attn_tile_sw(const Frame& F, ldsp KT, ldsp VT, f32x4 (&o)[8], float& m, float& z, float scale2, MaskF mask) {
    const int c = F.lane & 15, g4 = F.lane >> 4, q = 4 * F.wave + (c >> 2);
    f32x4 s[4];
    { bf16x8 qa[4];
#pragma unroll
      for (int ks = 0; ks < 4; ++ks) qa[ks] = *(LAS bf16x8*)(F.lds + AL_Q + (16 * F.wave + c) * KT_PITCH + (32 * ks + 8 * g4) * 2);
#pragma unroll
      for (int nb = 0; nb < 4; ++nb) { s[nb] = (f32x4){0.f, 0.f, 0.f, 0.f};
#pragma unroll
          for (int ks = 0; ks < 4; ++ks) { const bf16x8 kb = *(LAS bf16x8*)(KT + (16 * nb + c) * KT_PITCH + (32 * ks + 8 * g4) * 2); s[nb] = mfma16(kb, qa[ks], s[nb]); } } }
    float mx = -INFINITY;
#pragma unroll
    for (int nb = 0; nb < 4; ++nb)
#pragma unroll
        for (int j = 0; j < 4; ++j) { const float v = mask(q, 16 * nb + 4 * g4 + j) ? s[nb][j] * scale2 : -INFINITY; s[nb][j] = v; mx = fmaxf(mx, v); }
    mx = rowgrp_max(mx);
    const float mo = m, mn = fmaxf(mo, mx), mu = (mn == -INFINITY) ? 0.f : mn, al = __builtin_amdgcn_exp2f(mo - mu); float rs = 0.f;
#pragma unroll
    for (int nb = 0; nb < 4; ++nb)
#pragma unroll
        for (int j = 0; j < 4; ++j) { const float p = __builtin_amdgcn_exp2f(s[nb][j] - mu); s[nb][j] = p; rs += p; }
    rs = rowgrp_sum(rs); z = z * al + rs; m = mn;
#pragma unroll
    for (int j = 0; j < 4; ++j) { const float aj = __shfl(al, (F.lane & 48) | (4 * g4 + j));
#pragma unroll
        for (int ne = 0; ne < 8; ++ne) o[ne][j] *= aj; }
    const unsigned vbase = lds_addr(VT) + (unsigned)((4 * g4 + (c >> 2)) * KT_PITCH + (c & 3) * 8);
#pragma unroll
    for (int ks = 0; ks < 2; ++ks) { bf16x8 pa; { const unsigned w0 = cvt_pk_bf16(s[2 * ks][0], s[2 * ks][1]), w1 = cvt_pk_bf16(s[2 * ks][2], s[2 * ks][3]), w2 = cvt_pk_bf16(s[2 * ks + 1][0], s[2 * ks + 1][1]), w3 = cvt_pk_bf16(s[2 * ks + 1][2], s[2 * ks + 1][3]);
            const u32x4 pw = (u32x4){w0, w1, w2, w3}; pa = __builtin_bit_cast(bf16x8, pw); }
#pragma unroll
        for (int ne = 0; ne < 8; ne += 2) { bf16x8 v0, v1; const unsigned vb = vbase + 32 * ks * KT_PITCH + 32 * ne; tr_frag2s(vb, vb + 32, 16 * KT_PITCH, v0, v1);
            o[ne] = mfma16(pa, v0, o[ne]); o[ne + 1] = mfma16(pa, v1, o[ne + 1]); } }
}
template <bool WK, bool WV, class GetF, class BodyF> __device__ __forceinline__ void tile_pipeline(const Frame& F, int ntile, int ld, int lim, GetF get, BodyF body) {
    if (ntile <= 0) return;
    TileRegs R; const bf16_t* kp; const bf16_t* vp; int pos0;
    __syncthreads();
    get(0, kp, vp, pos0); tile_prefetch<WK, WV>(F, kp, vp, ld, pos0, lim, R); tile_commit<WK, WV>(F, F.lds + AL_KT0, F.lds + AL_VT0, R);
    __syncthreads();
    for (int i = 0; i < ntile; ++i) {
        const int cb = i & 1; const bool more = (i + 1 < ntile);
        if (more) { get(i + 1, kp, vp, pos0); tile_prefetch<WK, WV>(F, kp, vp, ld, pos0, lim, R); }
        body(i, F.lds + (cb ? AL_KT1 : AL_KT0), F.lds + (cb ? AL_VT1 : AL_VT0));
        if (more) tile_commit<WK, WV>(F, F.lds + (cb ? AL_KT0 : AL_KT1), F.lds + (cb ? AL_VT0 : AL_VT1), R);
        __syncthreads();
    }
}

__device__ __forceinline__ void swa_phase(const Frame& F0) { PHASE_FRAME(F0);
    const bf16_t* PROJ = (const bf16_t*)(F.ws + WS_PROJ); bf16_t* MIX = (bf16_t*)(F.ws + WS_MIX);
    ldsp PWw = F.lds + AL_PW + F.wave * AL_PWW;
    const float scale2 = 0.08838834764831845f * LOG2E;
    const int c = F.lane & 15, g4 = F.lane >> 4;
    for (int k = 0; k * F.G + F.bid < 2048; ++k) {
        const int ui = k * F.G + F.bid, kk = ui >> 8, bg = ((ui & 7) + 8 * (kk >> 2)) & 15, qb = (((ui >> 3) & 31) + 32 * (kk & 3)) & 127;
        const int b = bg >> 1, g = bg & 1, start = qb * 32, cur = qb >> 1; const size_t row0 = (size_t)b * SEQ + start;
        __syncthreads(); stage_q(F, PROJ + row0 * LDP + C_SQ + g * 512);
        f32x4 o[8];
#pragma unroll
        for (int ne = 0; ne < 8; ++ne) o[ne] = (f32x4){0.f, 0.f, 0.f, 0.f};
        float msw = F.in[8][g * 4 + (c & 3)] * LOG2E, zsw = 1.f;
        const int t0 = cur >= 2 ? cur - 2 : 0, nt = cur - t0 + 1;
        const bf16_t* kb = PROJ + (size_t)b * SEQ * LDP + C_SK + g * 128; const bf16_t* vbp = PROJ + (size_t)b * SEQ * LDP + C_SV + g * 128;
        tile_pipeline<true, true>(F, nt, LDP, SEQ,
            [&](int ti, const bf16_t*& kp, const bf16_t*& vp, int& pos0) { pos0 = (t0 + ti) * 64; kp = kb + (size_t)pos0 * LDP; vp = vbp + (size_t)pos0 * LDP; },
            [&](int ti, ldsp KT, ldsp VT) { const int pos0 = (t0 + ti) * 64;
                (void)PWw; attn_tile_sw(F, KT, VT, o, msw, zsw, scale2, [&](int q, int col) { const int rel = (start + q) - (pos0 + col); return rel >= 0 && rel < 128; }); });
#pragma unroll
        for (int j = 0; j < 4; ++j) { const float inv = 1.0f / __shfl(zsw, (F.lane & 48) | (4 * g4 + j)); bf16_t* orow = MIX + row0 * DM + 1024 + (g * 4 + j) * 128; const unsigned oo = (unsigned)((4 * F.wave + g4) * DM + c);
            unsigned char* orow8 = (unsigned char*)(F.ws + WS_MIX8) + row0 * DM + 1024 + (g * 4 + j) * 128;
#pragma unroll
            for (int ne = 0; ne < 8; ++ne) { if constexpr (OUT_FP8) orow8[oo + 16 * ne] = f2fp8(o[ne][j] * inv * ACT8_SCALE); else orow[oo + 16 * ne] = f2bf(o[ne][j] * inv); } }
    }
    __syncthreads();
}

constexpr int HS_G = 0, HS_KT = 4096, HS_VT = HS_KT + 128 * 144;
__device__ __forceinline__ void hgrn_s1_phase(const Frame& F0) { PHASE_FRAME(F0);
    const bf16_t* PROJ = (const bf16_t*)(F.ws + WS_PROJ); const float* LB = (const float*)(F.ws + WS_LB);
    bf16_t* DS = (bf16_t*)(F.ws + WS_DS); float* DEC = (float*)(F.ws + WS_DEC);
    const int dp = F.lane, sg = F.wave, c = F.lane & 15, g4 = F.lane >> 4;
    LAS float* GT = (LAS float*)(F.lds + HS_G);
    unsigned nzf[8], nzv[8];
    auto s1_load = [&](int u) { const int b = u >> 9, h = (u >> 6) & 7, n = u & 63; const size_t r0 = (size_t)b * SEQ + n * 64;
#pragma unroll
        for (int j = 0; j < 8; ++j) { const bf16_t* rp = PROJ + (r0 + 8 * sg + j) * LDP + h * 128 + 2 * dp; nzf[j] = *(const unsigned*)(rp + C_HF); nzv[j] = *(const unsigned*)(rp + C_HI); } };
    if (F.bid < 4096) s1_load(F.bid);
    for (int u = F.bid; u < 4096; u += F.G) {
        const int b = u >> 9, h = (u >> 6) & 7, n = u & 63; const size_t r0 = (size_t)b * SEQ + n * 64; (void)r0; (void)b; (void)n;
        const float lb0 = LB[h * 128 + 2 * dp], lb1 = LB[h * 128 + 2 * dp + 1];
        unsigned zf[8], zv[8];
#pragma unroll
        for (int j = 0; j < 8; ++j) { zf[j] = nzf[j]; zv[j] = nzv[j]; }
        float c0[8], c1[8], k0[8], k1[8]; float a0 = 0.f, a1 = 0.f;
#pragma unroll
        for (int j = 0; j < 8; ++j) { const float s0 = sigmoidf_(bflo(zf[j])), s1 = sigmoidf_(bfhi(zf[j]));
            a0 += __logf(lb0 + (1.f - lb0) * s0); a1 += __logf(lb1 + (1.f - lb1) * s1); c0[j] = a0; c1[j] = a1; k0[j] = (1.f - lb0) * (1.f - s0); k1[j] = (1.f - lb1) * (1.f - s1); }
        GT[sg * 128 + 2 * dp] = a0; GT[sg * 128 + 2 * dp + 1] = a1;
        __syncthreads();
        float pre0 = 0.f, pre1 = 0.f, tot0 = 0.f, tot1 = 0.f;
#pragma unroll
        for (int s = 0; s < 8; ++s) { const float x0 = GT[s * 128 + 2 * dp], x1 = GT[s * 128 + 2 * dp + 1]; if (s < sg) { pre0 += x0; pre1 += x1; } tot0 += x0; tot1 += x1; }
        float e0[8], e1[8];
#pragma unroll
        for (int j = 0; j < 8; ++j) { e0[j] = k0[j] * __expf(tot0 - (pre0 + c0[j])); e1[j] = k1[j] * __expf(tot1 - (pre1 + c1[j])); }
        u32x4 w0, w1, v0, v1;
        w0.x = pk2(e0[0], e0[1]); w0.y = pk2(e0[2], e0[3]); w0.z = pk2(e0[4], e0[5]); w0.w = pk2(e0[6], e0[7]);
        w1.x = pk2(e1[0], e1[1]); w1.y = pk2(e1[2], e1[3]); w1.z = pk2(e1[4], e1[5]); w1.w = pk2(e1[6], e1[7]);
        v0.x = (zv[0] & 0xffffu) | (zv[1] << 16); v0.y = (zv[2] & 0xffffu) | (zv[3] << 16); v0.z = (zv[4] & 0xffffu) | (zv[5] << 16); v0.w = (zv[6] & 0xffffu) | (zv[7] << 16);
        v1.x = (zv[0] >> 16) | (zv[1] & 0xffff0000u); v1.y = (zv[2] >> 16) | (zv[3] & 0xffff0000u); v1.z = (zv[4] >> 16) | (zv[5] & 0xffff0000u); v1.w = (zv[6] >> 16) | (zv[7] & 0xffff0000u);
        *(LAS u32x4*)(F.lds + HS_KT + (2 * dp) * 144 + 16 * sg) = w0; *(LAS u32x4*)(F.lds + HS_KT + (2 * dp + 1) * 144 + 16 * sg) = w1;
        *(LAS u32x4*)(F.lds + HS_VT + (2 * dp) * 144 + 16 * sg) = v0; *(LAS u32x4*)(F.lds + HS_VT + (2 * dp + 1) * 144 + 16 * sg) = v1;
        if (sg == 0) { DEC[(size_t)u * 128 + 2 * dp] = __expf(tot0); DEC[(size_t)u * 128 + 2 * dp + 1] = __expf(tot1); }
        if (u + F.G < 4096) s1_load(u + F.G);
        __syncthreads();
        f32x4 acc[8];
#pragma unroll
        for (int nb = 0; nb < 8; ++nb) acc[nb] = (f32x4){0.f, 0.f, 0.f, 0.f};
#pragma unroll
        for (int ks = 0; ks < 2; ++ks) { const bf16x8 va = *(LAS bf16x8*)(F.lds + HS_VT + (16 * F.wave + c) * 144 + (32 * ks + 8 * g4) * 2);
#pragma unroll
            for (int nb = 0; nb < 8; ++nb) { const bf16x8 kb = *(LAS bf16x8*)(F.lds + HS_KT + (16 * nb + c) * 144 + (32 * ks + 8 * g4) * 2); acc[nb] = mfma16(kb, va, acc[nb]); } }
        bf16_t* dst = DS + (size_t)u * 16384;
#pragma unroll
        for (int nb = 0; nb < 8; ++nb) { u32x2 o; o.x = pk2(acc[nb][0], acc[nb][1]); o.y = pk2(acc[nb][2], acc[nb][3]); *(u32x2*)(dst + (16 * F.wave + c) * 128 + 16 * nb + 4 * g4) = o; }
        __syncthreads();
    }
}
__device__ __forceinline__ void hgrn_scan_phase(const Frame& F0) { PHASE_FRAME(F0);
    const bf16_t* DS = (const bf16_t*)(F.ws + WS_DS); const float* DEC = (const float*)(F.ws + WS_DEC); bf16_t* SP = (bf16_t*)(F.ws + WS_SPREV);
    for (int item = F.bid * NTHR + F.tid; item < 64 * 4096; item += F.G * NTHR) {
        const int bh = item >> 12, q4 = item & 4095, d0 = (4 * q4) & 127;
        float4 st = make_float4(0.f, 0.f, 0.f, 0.f);
#pragma unroll 8
        for (int n = 0; n < 64; ++n) { const size_t u = (size_t)bh * 64 + n;
            const u32x2 dsw = *(const u32x2*)(DS + u * 16384 + 4 * q4); const float4 ds = make_float4(bflo(dsw.x), bfhi(dsw.x), bflo(dsw.y), bfhi(dsw.y)), dc = *(const float4*)(DEC + u * 128 + d0);
            u32x2 o; o.x = pk2(st.x, st.y); o.y = pk2(st.z, st.w); *(u32x2*)(SP + u * 16384 + 4 * q4) = o;
            st.x = dc.x * st.x + ds.x; st.y = dc.y * st.y + ds.y; st.z = dc.z * st.z + ds.z; st.w = dc.w * st.w + ds.w; }
    }
}
constexpr int H3_G = 0, H3_QT = 4096, H3_QH = H3_QT + 64 * KT_PITCH, H3_VN = H3_QH + 64 * KT_PITCH, H3_KH = H3_VN + 64 * KT_PITCH, H3_PW = H3_KH + 160 * KT_PITCH, H3_SSQ = H3_PW + NWAVE * 16 * PW_PITCH, H3_END = H3_SSQ + 512;
static_assert(H3_END <= LDS_BYTES - 64, "hgrn s3 LDS");
__device__ __forceinline__ void hgrn_s3_phase(const Frame& F0) { PHASE_FRAME(F0);
    const bf16_t* PROJ = (const bf16_t*)(F.ws + WS_PROJ); const float* LB = (const float*)(F.ws + WS_LB); const bf16_t* SP = (const bf16_t*)(F.ws + WS_SPREV); bf16_t* MIX = (bf16_t*)(F.ws + WS_MIX);
    const int dp = F.lane, sg = F.wave, c = F.lane & 15, g4 = F.lane >> 4;
    LAS float* GT = (LAS float*)(F.lds + H3_G); LAS float* SSQ = (LAS float*)(F.lds + H3_SSQ);
    unsigned nzf[8], nzq[8]; u32x4 nvt[2];
    auto s3_load = [&](int u) { const int b = u >> 9, h = (u >> 6) & 7, n = u & 63; const size_t r0 = (size_t)b * SEQ + n * 64;
#pragma unroll
        for (int j = 0; j < 8; ++j) { const bf16_t* rp = PROJ + (r0 + 8 * sg + j) * LDP + h * 128 + 2 * dp; nzf[j] = *(const unsigned*)(rp + C_HF); nzq[j] = *(const unsigned*)(rp + C_HQ); }
#pragma unroll
        for (int i = 0; i < 2; ++i) { const int id = F.tid + NTHR * i, r = id >> 4, ch = id & 15; nvt[i] = *(const u32x4*)(PROJ + r0 * LDP + C_HI + h * 128 + (unsigned)(r * LDP + ch * 8)); } };
    if (F.bid < 4096) s3_load(F.bid);
    for (int u = F.bid; u < 4096; u += F.G) {
        const int b = u >> 9, h = (u >> 6) & 7, n = u & 63; const size_t r0 = (size_t)b * SEQ + n * 64; (void)b; (void)n;
        const float lb0 = LB[h * 128 + 2 * dp], lb1 = LB[h * 128 + 2 * dp + 1];
        unsigned zf[8], zq[8];
#pragma unroll
        for (int j = 0; j < 8; ++j) { zf[j] = nzf[j]; zq[j] = nzq[j]; }
#pragma unroll
        for (int i = 0; i < 2; ++i) { const int id = F.tid + NTHR * i, r = id >> 4, ch = id & 15; *(LAS u32x4*)(F.lds + H3_VN + r * KT_PITCH + ch * 16) = nvt[i]; }
        float c0[8], c1[8], k0[8], k1[8]; float a0 = 0.f, a1 = 0.f;
#pragma unroll
        for (int j = 0; j < 8; ++j) { const float s0 = sigmoidf_(bflo(zf[j])), s1 = sigmoidf_(bfhi(zf[j]));
            a0 += __logf(lb0 + (1.f - lb0) * s0); a1 += __logf(lb1 + (1.f - lb1) * s1); c0[j] = a0; c1[j] = a1; k0[j] = (1.f - lb0) * (1.f - s0); k1[j] = (1.f - lb1) * (1.f - s1); }
        GT[sg * 128 + 2 * dp] = a0; GT[sg * 128 + 2 * dp + 1] = a1;
        __syncthreads();
        float pre0 = 0.f, pre1 = 0.f, rf0[4], rf1[4]; { float x0 = 0.f, x1 = 0.f;
#pragma unroll
            for (int s = 0; s < 8; ++s) { if ((s & 1) == 0) { rf0[s >> 1] = x0; rf1[s >> 1] = x1; } if (s == sg) { pre0 = x0; pre1 = x1; } x0 += GT[s * 128 + 2 * dp]; x1 += GT[s * 128 + 2 * dp + 1]; } }
        const int blk = sg >> 1;
        float rb0 = rf0[0], rb1 = rf1[0];
#pragma unroll
        for (int i = 1; i < 4; ++i) if (i == blk) { rb0 = rf0[i]; rb1 = rf1[i]; }
#pragma unroll
        for (int j = 0; j < 8; ++j) { const int s = 8 * sg + j; const float q0 = bflo(zq[j]), q1 = bfhi(zq[j]), b0 = pre0 + c0[j], b1 = pre1 + c1[j];
            *(LAS unsigned*)(F.lds + H3_QT + s * KT_PITCH + 4 * dp) = pk2(q0 * __expf(b0), q1 * __expf(b1));
            *(LAS unsigned*)(F.lds + H3_QH + s * KT_PITCH + 4 * dp) = pk2(q0 * __expf(b0 - rb0), q1 * __expf(b1 - rb1));
#pragma unroll
            for (int i = 0; i < 4; ++i) if (i >= blk) { const int base = (i == 0) ? 0 : (i == 1) ? 16 : (i == 2) ? 48 : 96;
                *(LAS unsigned*)(F.lds + H3_KH + (base + s) * KT_PITCH + 4 * dp) = pk2(k0[j] * __expf(rf0[i] - b0), k1[j] * __expf(rf1[i] - b1)); } }
        __syncthreads();
        if (u + F.G < 4096) s3_load(u + F.G);
        const int ti = F.wave & 3, eh = F.wave >> 2, kbase = (ti == 0) ? 0 : (ti == 1) ? 16 : (ti == 2) ? 48 : 96;
        bf16x8 sbr[4][4];
        { const bf16_t* sp = SP + (size_t)u * 16384;
#pragma unroll
          for (int ks = 0; ks < 4; ++ks)
#pragma unroll
            for (int ne = 0; ne < 4; ++ne) sbr[ks][ne] = *(const bf16x8*)(sp + (64 * eh + 16 * ne + c) * 128 + 32 * ks + 8 * g4); }
        ldsp PWw = F.lds + H3_PW + F.wave * 16 * PW_PITCH;
        {
            bf16x8 qa[4];
#pragma unroll
            for (int ks = 0; ks < 4; ++ks) qa[ks] = *(LAS bf16x8*)(F.lds + H3_QH + (16 * ti + c) * KT_PITCH + (32 * ks + 8 * g4) * 2);
#pragma unroll
            for (int nb = 0; nb < 4; ++nb) { f32x4 s = (f32x4){0.f, 0.f, 0.f, 0.f};
                if (nb <= ti) {
#pragma unroll
                    for (int ks = 0; ks < 4; ++ks) { const bf16x8 kb = *(LAS bf16x8*)(F.lds + H3_KH + (kbase + 16 * nb + c) * KT_PITCH + (32 * ks + 8 * g4) * 2); s = mfma16(qa[ks], kb, s); }
                }
#pragma unroll
                for (int j = 0; j < 4; ++j) { const float v = (nb < ti || (nb == ti && c <= 4 * g4 + j)) ? s[j] : 0.f; *(LAS bf16_t*)(PWw + (4 * g4 + j) * PW_PITCH + (16 * nb + c) * 2) = f2bf(v); } }
        }
        LDS_FENCE();
        f32x4 o[4];
#pragma unroll
        for (int ne = 0; ne < 4; ++ne) o[ne] = (f32x4){0.f, 0.f, 0.f, 0.f};
        const unsigned vbase = lds_addr(F.lds + H3_VN) + tr_lane_off(F.lane, KT_PITCH) + 128 * eh;
#pragma unroll
        for (int ks = 0; ks < 2; ++ks) { const bf16x8 pa = *(LAS bf16x8*)(PWw + c * PW_PITCH + (32 * ks + 8 * g4) * 2);
#pragma unroll
            for (int ne = 0; ne < 4; ne += 2) { bf16x8 v0, v1; tr_frag2(vbase + 32 * ks * KT_PITCH + 32 * ne, vbase + 32 * ks * KT_PITCH + 32 * (ne + 1), KT_PITCH, v0, v1); o[ne] = mfma16(pa, v0, o[ne]); o[ne + 1] = mfma16(pa, v1, o[ne + 1]); } }
#pragma unroll
        for (int ks = 0; ks < 4; ++ks) { const bf16x8 qa = *(LAS bf16x8*)(F.lds + H3_QT + (16 * ti + c) * KT_PITCH + (32 * ks + 8 * g4) * 2);
#pragma unroll
            for (int ne = 0; ne < 4; ++ne) o[ne] = mfma16(qa, sbr[ks][ne], o[ne]); }
#pragma unroll
        for (int j = 0; j < 4; ++j) { float ss = 0.f;
#pragma unroll
            for (int ne = 0; ne < 4; ++ne) ss += o[ne][j] * o[ne][j];
            ss = grp16_sum(ss); if (c == 0) SSQ[eh * 64 + 16 * ti + 4 * g4 + j] = ss; }
        __syncthreads();
        bf16_t gtv[4][4]; float nw[4];
#pragma unroll
        for (int ne = 0; ne < 4; ++ne) nw[ne] = F.in[7][h * 128 + 64 * eh + 16 * ne + c];
#pragma unroll
        for (int j = 0; j < 4; ++j)
#pragma unroll
            for (int ne = 0; ne < 4; ++ne) gtv[j][ne] = PROJ[(r0 + 16 * ti + 4 * g4 + j) * LDP + C_HG + h * 128 + 64 * eh + 16 * ne + c];
#pragma unroll
        for (int j = 0; j < 4; ++j) { const int t = 16 * ti + 4 * g4 + j; const float rstd = rsqrtf((SSQ[t] + SSQ[64 + t]) * (1.0f / 128.f) + RMS_EPS);
#pragma unroll
            for (int ne = 0; ne < 4; ++ne) { const int e = 64 * eh + 16 * ne + c; const float gt = bf2f(gtv[j][ne]);
                const float val = o[ne][j] * rstd * nw[ne] * gt * sigmoidf_(gt);
                if constexpr (OUT_FP8) ((unsigned char*)(F.ws + WS_MIX8))[(r0 + t) * DM + h * 128 + e] = f2fp8(val * ACT8_SCALE); else MIX[(r0 + t) * DM + h * 128 + e] = f2bf(val); } }
        __syncthreads();
    }
}
__device__ __forceinline__ void rot_sincos(float pos, float theta, float& sn, float& cs) {
    const float ang = pos * theta; double r = (double)ang * 0.15915494309189535; r -= floor(r); const float fr = (float)r;
    sn = __builtin_amdgcn_sinf(fr); cs = __builtin_amdgcn_cosf(fr);
}
__device__ __forceinline__ float ret_log2g(int h) { return log2f(1.0f - exp2f(-5.0f - (float)h)); }
constexpr int RT_KZ = 0, RT_V = 128 * KT_PITCH, RV_PITCH = 528, RT_PW = RT_V + 128 * RV_PITCH, RT_TH = RT_PW + NWAVE * 16 * KT_PITCH, RT_END = RT_TH + 256 + 1024;
static_assert(RT_END <= LDS_BYTES - 64, "retention LDS");
template <class PowF> __device__ __forceinline__ void ret_stage_rot(const Frame& F, ldsp dst, const bf16_t* src_row0, int pos_base, float mul, PowF pw) {
    const int tok = F.tid >> 2, qtr = F.tid & 3; const LAS float* TH = (const LAS float*)(F.lds + RT_TH);
    const bf16_t* rp = src_row0 + (size_t)tok * LDP + 16 * qtr;
    u32x4 a0 = *(const u32x4*)rp, a1 = *(const u32x4*)(rp + 8), b0 = *(const u32x4*)(rp + 64), b1 = *(const u32x4*)(rp + 72);
    unsigned xa[8] = {a0.x, a0.y, a0.z, a0.w, a1.x, a1.y, a1.z, a1.w}, xb[8] = {b0.x, b0.y, b0.z, b0.w, b1.x, b1.y, b1.z, b1.w}, oa[8], ob[8];
    const float sc = mul * pw(tok);
#pragma unroll
    for (int i = 0; i < 8; ++i) { float s0, c0, s1, c1; rot_sincos((float)(pos_base + tok), TH[16 * qtr + 2 * i], s0, c0); rot_sincos((float)(pos_base + tok), TH[16 * qtr + 2 * i + 1], s1, c1);
        const float x1l = bflo(xa[i]), x1h = bfhi(xa[i]), x2l = bflo(xb[i]), x2h = bfhi(xb[i]);
        oa[i] = pk2((x1l * c0 - x2l * s0) * sc, (x1h * c1 - x2h * s1) * sc); ob[i] = pk2((x2l * c0 + x1l * s0) * sc, (x2h * c1 + x1h * s1) * sc); }
    *(LAS u32x4*)(dst + tok * KT_PITCH + 32 * qtr) = (u32x4){oa[0], oa[1], oa[2], oa[3]}; *(LAS u32x4*)(dst + tok * KT_PITCH + 32 * qtr + 16) = (u32x4){oa[4], oa[5], oa[6], oa[7]};
    *(LAS u32x4*)(dst + tok * KT_PITCH + 128 + 32 * qtr) = (u32x4){ob[0], ob[1], ob[2], ob[3]}; *(LAS u32x4*)(dst + tok * KT_PITCH + 128 + 32 * qtr + 16) = (u32x4){ob[4], ob[5], ob[6], ob[7]};
}
__device__ __forceinline__ void ret_stage_v(const Frame& F, ldsp dst, const bf16_t* src_row0) {
#pragma unroll
    for (int i = 0; i < 8; ++i) { const int id = F.tid + NTHR * i, r = id >> 5, ch = id & 31; *(LAS u32x4*)(dst + r * RV_PITCH + ch * 16) = *(const u32x4*)(src_row0 + (size_t)r * LDP + ch * 8); }
}
__device__ __forceinline__ void ret_theta(const Frame& F) { if (F.tid < 64) ((LAS float*)(F.lds + RT_TH))[F.tid] = exp2f(-13.287712379549449f * (float)F.tid * (1.0f / 63.0f)); }
__device__ __forceinline__ void ret_s1_phase(const Frame& F0) { PHASE_FRAME(F0);
    const bf16_t* PROJ = (const bf16_t*)(F.ws + WS_PROJ); bf16_t* KV = (bf16_t*)(F.ws + WS_KV);
    const int c = F.lane & 15, g4 = F.lane >> 4;
    __syncthreads(); ret_theta(F); __syncthreads();
    for (int u = F.bid; u < 1024; u += F.G) {
        const int b = u >> 7, h = (u >> 5) & 3, n = u & 31; const size_t r0 = (size_t)b * SEQ + n * 128; const float l2g = ret_log2g(h);
        ret_stage_rot(F, F.lds + RT_KZ, PROJ + r0 * LDP + C_RK + h * 128, n * 128, 0.08838834764831845f, [&](int tok) { return exp2f(l2g * (float)(127 - tok)); });
        ret_stage_v(F, F.lds + RT_V, PROJ + r0 * LDP + C_RV + h * 256);
        __syncthreads();
        const unsigned vb = lds_addr(F.lds + RT_V) + tr_lane_off(F.lane, RV_PITCH) + 64 * F.wave, kb = lds_addr(F.lds + RT_KZ) + tr_lane_off(F.lane, KT_PITCH);
        bf16_t* dst = KV + (size_t)u * 32768;
#pragma unroll 1
        for (int a = 0; a < 2; ++a) {
            f32x4 acc[8];
#pragma unroll
            for (int nb = 0; nb < 8; ++nb) acc[nb] = (f32x4){0.f, 0.f, 0.f, 0.f};
#pragma unroll
            for (int ks = 0; ks < 4; ++ks) { const bf16x8 va = tr_frag(vb + 32 * ks * RV_PITCH + 32 * a, RV_PITCH);
#pragma unroll
                for (int nb = 0; nb < 8; nb += 2) { bf16x8 k0, k1; tr_frag2(kb + 32 * ks * KT_PITCH + 32 * nb, kb + 32 * ks * KT_PITCH + 32 * (nb + 1), KT_PITCH, k0, k1);
                    acc[nb] = mfma16(k0, va, acc[nb]); acc[nb + 1] = mfma16(k1, va, acc[nb + 1]); } }
#pragma unroll
            for (int nb = 0; nb < 8; ++nb) { u32x2 o; o.x = pk2(acc[nb][0], acc[nb][1]); o.y = pk2(acc[nb][2], acc[nb][3]); *(u32x2*)(dst + (unsigned)((32 * F.wave + 16 * a + c) * 128 + 16 * nb + 4 * g4)) = o; }
        }
        __syncthreads();
    }
}
__device__ __forceinline__ void ret_scan_phase(const Frame& F0) { PHASE_FRAME(F0);
    const bf16_t* KV = (const bf16_t*)(F.ws + WS_KV); bf16_t* RP = (bf16_t*)(F.ws + WS_RPREV);
    for (int item = F.bid * NTHR + F.tid; item < 32 * 8192; item += F.G * NTHR) {
        const int bh = item >> 13, q4 = item & 8191; const float cd = exp2f(128.0f * ret_log2g(bh & 3));
        float4 st = make_float4(0.f, 0.f, 0.f, 0.f);
#pragma unroll 8
        for (int n = 0; n < 32; ++n) { const size_t u = (size_t)bh * 32 + n; const u32x2 kw = *(const u32x2*)(KV + u * 32768 + 4 * q4); const float4 kv = make_float4(bflo(kw.x), bfhi(kw.x), bflo(kw.y), bfhi(kw.y));
            u32x2 o; o.x = pk2(st.x, st.y); o.y = pk2(st.z, st.w); *(u32x2*)(RP + u * 32768 + 4 * q4) = o;
            st.x = cd * st.x + kv.x; st.y = cd * st.y + kv.y; st.z = cd * st.z + kv.z; st.w = cd * st.w + kv.w; }
    }
}
__device__ __forceinline__ void ret_s3_phase(const Frame& F0) { PHASE_FRAME(F0);
    const bf16_t* PROJ = (const bf16_t*)(F.ws + WS_PROJ); const bf16_t* RP = (const bf16_t*)(F.ws + WS_RPREV); bf16_t* MIX = (bf16_t*)(F.ws + WS_MIX);
    const int c = F.lane & 15, g4 = F.lane >> 4; const LAS float* TH = (const LAS float*)(F.lds + RT_TH);
    LAS float* ST = (LAS float*)(F.lds + RT_TH + 256);
    __syncthreads(); ret_theta(F); __syncthreads();
    const int ti = F.wave & 3, eh = F.wave >> 2;
    for (int u = F.bid; u < 1024; u += F.G) {
        const int b = u >> 7, h = (u >> 5) & 3, n = u & 31; const size_t r0 = (size_t)b * SEQ + n * 128; const float l2g = ret_log2g(h);
        ret_stage_rot(F, F.lds + RT_KZ, PROJ + r0 * LDP + C_RK + h * 128, n * 128, 0.08838834764831845f, [&](int tok) { return exp2f(-l2g * (float)tok); });
        ret_stage_v(F, F.lds + RT_V, PROJ + r0 * LDP + C_RV + h * 256);
        __syncthreads();
        ldsp PWw = F.lds + RT_PW + F.wave * 16 * KT_PITCH;
        const bf16_t* rp = RP + (size_t)u * 32768 + (size_t)eh * 128 * 128;
        const float gam = exp2f(l2g);
#pragma unroll 1
        for (int pass = 0; pass < 2; ++pass) {
            const int tb = 4 * pass + ti;
            bf16x8 qf[4];
            { const int t = 16 * tb + c; const bf16_t* qp = PROJ + (r0 + t) * LDP + C_RQ + h * 128; const float sc = exp2f(l2g * (float)t);
#pragma unroll
              for (int ks = 0; ks < 2; ++ks) { const bf16x8 x1 = *(const bf16x8*)(qp + 32 * ks + 8 * g4), x2 = *(const bf16x8*)(qp + 64 + 32 * ks + 8 * g4);
#pragma unroll
                  for (int i = 0; i < 8; ++i) { float sn, cs; rot_sincos((float)(n * 128 + t), TH[32 * ks + 8 * g4 + i], sn, cs); const float a = bf2f((bf16_t)x1[i]), bb = bf2f((bf16_t)x2[i]);
                      qf[ks][i] = (short)f2bf((a * cs - bb * sn) * sc); qf[ks + 2][i] = (short)f2bf((bb * cs + a * sn) * sc); } } }
#pragma unroll
            for (int nb = 0; nb < 8; ++nb) { f32x4 s = (f32x4){0.f, 0.f, 0.f, 0.f};
                if (nb <= tb) {
#pragma unroll
                    for (int ks = 0; ks < 4; ++ks) { const bf16x8 kb = *(LAS bf16x8*)(F.lds + RT_KZ + (16 * nb + c) * KT_PITCH + (32 * ks + 8 * g4) * 2); s = mfma16(qf[ks], kb, s); } }
#pragma unroll
                for (int j = 0; j < 4; ++j) { const float v = (nb < tb || (nb == tb && c <= 4 * g4 + j)) ? s[j] : 0.f; *(LAS bf16_t*)(PWw + (4 * g4 + j) * KT_PITCH + (16 * nb + c) * 2) = f2bf(v); } }
            LDS_FENCE();
            f32x4 o[8];
#pragma unroll
            for (int ne = 0; ne < 8; ++ne) o[ne] = (f32x4){0.f, 0.f, 0.f, 0.f};
#pragma unroll
            for (int ks = 0; ks < 4; ++ks)
#pragma unroll
                for (int ne = 0; ne < 8; ++ne) { const bf16x8 rb = *(const bf16x8*)(rp + (unsigned)((16 * ne + c) * 128 + 32 * ks + 8 * g4)); o[ne] = mfma16(qf[ks], rb, o[ne]); }
#pragma unroll
            for (int ne = 0; ne < 8; ++ne) o[ne] *= gam;
            const unsigned vb = lds_addr(F.lds + RT_V) + tr_lane_off(F.lane, RV_PITCH) + 256 * eh;
#pragma unroll
            for (int ks = 0; ks < 4; ++ks) { const bf16x8 pa = *(LAS bf16x8*)(PWw + c * KT_PITCH + (32 * ks + 8 * g4) * 2);
#pragma unroll
                for (int ne = 0; ne < 8; ne += 2) { bf16x8 v0, v1; tr_frag2(vb + 32 * ks * RV_PITCH + 32 * ne, vb + 32 * ks * RV_PITCH + 32 * (ne + 1), RV_PITCH, v0, v1); o[ne] = mfma16(pa, v0, o[ne]); o[ne + 1] = mfma16(pa, v1, o[ne + 1]); } }
#pragma unroll
            for (int j = 0; j < 4; ++j) { float sm = 0.f, sq = 0.f;
#pragma unroll
                for (int ne = 0; ne < 8; ++ne) { sm += o[ne][j]; sq += o[ne][j] * o[ne][j]; }
                sm = grp16_sum(sm); sq = grp16_sum(sq);
                if (c == 0) { ST[(eh * 64 + 16 * ti + 4 * g4 + j) * 2] = sm; ST[(eh * 64 + 16 * ti + 4 * g4 + j) * 2 + 1] = sq; } }
            __syncthreads();
            const bf16_t* gp = PROJ + r0 * LDP + C_RG + h * 256 + 128 * eh; bf16_t* mp = MIX + r0 * DM + 1024 + h * 256 + 128 * eh; const float* np_ = F.in[17] + h * 256 + 128 * eh;
            float nw[8];
#pragma unroll
            for (int ne = 0; ne < 8; ++ne) nw[ne] = np_[16 * ne + c];
#pragma unroll
            for (int j = 0; j < 4; ++j) { const int rl64 = 16 * ti + 4 * g4 + j; const float sm = ST[rl64 * 2] + ST[(64 + rl64) * 2], sq = ST[rl64 * 2 + 1] + ST[(64 + rl64) * 2 + 1];
                const float mean = sm * (1.0f / 256.f), rstd = rsqrtf(fmaxf(sq * (1.0f / 256.f) - mean * mean, 0.f) + RMS_EPS); const unsigned rl = (unsigned)(16 * tb + 4 * g4 + j);
                bf16_t gtv[8];
#pragma unroll
                for (int ne = 0; ne < 8; ++ne) gtv[ne] = gp[rl * LDP + 16 * ne + c];
#pragma unroll
                for (int ne = 0; ne < 8; ++ne) { const unsigned e = 16 * ne + c; const float gt = bf2f(gtv[ne]);
                    const float val = (o[ne][j] - mean) * rstd * nw[ne] * gt * sigmoidf_(gt);
                    if constexpr (OUT_FP8) ((unsigned char*)(F.ws + WS_MIX8) + r0 * DM + 1024 + h * 256 + 128 * eh)[rl * DM + e] = f2fp8(val * ACT8_SCALE); else mp[rl * DM + e] = f2bf(val); } }
            __syncthreads();
        }
    }
}

__device__ __forceinline__ float gelu_tanh(float x) { const float y = 0.7978845608028654f * (x + 0.044715f * x * x * x); return x * (1.0f - __builtin_amdgcn_rcpf(1.0f + __expf(2.0f * y))); }
constexpr int CP_ROWS = 528, CP_H = CP_ROWS * 256;
static_assert(CP_H + 32 * KT_PITCH <= LDS_BYTES - 64, "nsa compress LDS");
__device__ __forceinline__ void nsa_compress_phase(const Frame& F0) { PHASE_FRAME(F0);
    const bf16_t* PROJ = (const bf16_t*)(F.ws + WS_PROJ); bf16_t* KC = (bf16_t*)(F.ws + WS_KCMP);
    const int c = F.lane & 15, g4 = F.lane >> 4;
    for (int u = F.bid; u < 256; u += F.G) {
        const int kv = u >> 7, b = (u >> 4) & 7, g = (u >> 3) & 1, nt = u & 7; const bool ok0 = 32 * nt + c <= 254, ok1 = 32 * nt + 16 + c <= 254;
        const bf16_t* src = PROJ + ((size_t)b * SEQ + 512 * nt) * LDP + (kv ? C_NVC : C_NKC) + g * 128; const int rmax = SEQ - 1 - 512 * nt;
        __syncthreads();
        { u32x4 st[17];
#pragma unroll
          for (int i = 0; i < 17; ++i) { const int id = F.tid + NTHR * i, r = id >> 4, ch = id & 15; const int rr = r < rmax ? r : rmax; st[i] = *(const u32x4*)(src + (unsigned)(rr * LDP + ch * 8)); }
#pragma unroll
          for (int i = 0; i < 17; ++i) { const int id = F.tid + NTHR * i, r = id >> 4, ch = id & 15; if (r < CP_ROWS) *(LAS u32x4*)(F.lds + r * 256 + ((ch ^ ((r >> 4) & 15)) << 4)) = st[i]; } }
        const bf16_t* wp = (const bf16_t*)(F.ws + WS_NW1) + (size_t)kv * 128 * 4096 + (size_t)(16 * F.wave + c) * 4096 + 8 * g4;
        f32x4 acc[2][4];
#pragma unroll
        for (int a = 0; a < 2; ++a)
#pragma unroll
            for (int i = 0; i < 4; ++i) acc[a][i] = (f32x4){0.f, 0.f, 0.f, 0.f};
        __syncthreads();
#pragma unroll 1
        for (int lh = 0; lh < 2; ++lh) {
            const int sw = (c + lh) & 15; const unsigned abase = lds_addr(F.lds) + (unsigned)((16 * c + 16 * lh) * 256);
#pragma unroll 4
            for (int ll = 0; ll < 16; ++ll) {
#pragma unroll
                for (int k4 = 0; k4 < 4; ++k4) { const unsigned ad = abase + ll * 256 + (((4 * k4 + g4) ^ sw) << 4);
                    bf16x8 a0 = *(LAS bf16x8*)(size_t)ad, a1 = *(LAS bf16x8*)(size_t)(ad + 256 * 256);
                    if (!ok0) a0 = (bf16x8){0, 0, 0, 0, 0, 0, 0, 0}; if (!ok1) a1 = (bf16x8){0, 0, 0, 0, 0, 0, 0, 0};
                    const bf16x8 w = *(const bf16x8*)(wp + 128 * (16 * lh + ll) + 32 * k4); acc[0][k4] = mfma16(a0, w, acc[0][k4]); acc[1][k4] = mfma16(a1, w, acc[1][k4]); } } }
        float bias = 0.f; for (int jj = 0; jj < 16; ++jj) bias += ((const float*)(F.ws + WS_NBIAS))[(kv * 16 + jj) * 128 + 16 * F.wave + c];
#pragma unroll
        for (int a = 0; a < 2; ++a) { const f32x4 hs = (acc[a][0] + acc[a][1]) + (acc[a][2] + acc[a][3]);
#pragma unroll
            for (int j = 0; j < 4; ++j) *(LAS bf16_t*)(F.lds + CP_H + (16 * a + 4 * g4 + j) * KT_PITCH + (16 * F.wave + c) * 2) = f2bf(gelu_tanh(hs[j] + bias)); }
        __syncthreads();
        const bf16_t* w2 = (const bf16_t*)(F.ws + WS_NW2) + (size_t)kv * 128 * 128 + (size_t)(16 * F.wave + c) * 128 + 8 * g4;
        f32x4 o[2] = {(f32x4){0.f, 0.f, 0.f, 0.f}, (f32x4){0.f, 0.f, 0.f, 0.f}};
#pragma unroll
        for (int ks = 0; ks < 4; ++ks) { const bf16x8 w = *(const bf16x8*)(w2 + 32 * ks);
#pragma unroll
            for (int a = 0; a < 2; ++a) { const bf16x8 x = *(LAS bf16x8*)(F.lds + CP_H + (16 * a + c) * KT_PITCH + (32 * ks + 8 * g4) * 2); o[a] = mfma16(x, w, o[a]); } }
        bf16_t* dst = KC + ((size_t)(kv * 8 + b) * 2 + g) * 256 * 128;
#pragma unroll
        for (int a = 0; a < 2; ++a)
#pragma unroll
            for (int j = 0; j < 4; ++j) { const int nn = 32 * nt + 16 * a + 4 * g4 + j; dst[nn * 128 + 16 * F.wave + c] = (nn <= 254) ? f2bf(o[a][j]) : (bf16_t)0; }
    }
    __syncthreads();
}
constexpr int N2_Q = 4 * TILE_B, N2_IMP = N2_Q + 256 * KT_PITCH, N2_SEL = N2_IMP + 64 * 64 * 4, N2_LIST = N2_SEL + 512, N2_END = N2_LIST + 64;
static_assert(N2_END <= LDS_BYTES - 64, "nsa LDS");
__device__ __forceinline__ void stage_q2(const Frame& F, const bf16_t* qbase) {
#pragma unroll
    for (int i = 0; i < 8; ++i) { const int id = F.tid + NTHR * i, row = id >> 4, ch = id & 15;
        *(LAS u32x4*)(F.lds + N2_Q + row * KT_PITCH + ch * 16) = *(const u32x4*)(qbase + (unsigned)((row >> 2) * LDP + (row & 3) * 128 + ch * 8)); }
}
__device__ __forceinline__ void scores2(const Frame& F, ldsp KT, f32x4 (&s)[2][4]) {
    const int c = F.lane & 15, g4 = F.lane >> 4;
#pragma unroll
    for (int a = 0; a < 2; ++a)
#pragma unroll
        for (int nb = 0; nb < 4; ++nb) s[a][nb] = (f32x4){0.f, 0.f, 0.f, 0.f};
#pragma unroll
    for (int ks = 0; ks < 4; ++ks) {
        const bf16x8 q0 = *(LAS bf16x8*)(F.lds + N2_Q + (32 * F.wave + c) * KT_PITCH + (32 * ks + 8 * g4) * 2), q1 = *(LAS bf16x8*)(F.lds + N2_Q + (32 * F.wave + 16 + c) * KT_PITCH + (32 * ks + 8 * g4) * 2);
#pragma unroll
        for (int nb = 0; nb < 4; ++nb) { const bf16x8 kb = *(LAS bf16x8*)(KT + (16 * nb + c) * KT_PITCH + (32 * ks + 8 * g4) * 2); s[0][nb] = mfma16(kb, q0, s[0][nb]); s[1][nb] = mfma16(kb, q1, s[1][nb]); } }
}
__device__ __forceinline__ void pv2(const Frame& F, ldsp VT, const f32x4 (&s)[2][4], const float (&pg)[2], f32x4 (&o)[2][8]) {
    const int c = F.lane & 15, g4 = F.lane >> 4;
    const unsigned vbase = lds_addr(VT) + (unsigned)((4 * g4 + (c >> 2)) * KT_PITCH + (c & 3) * 8);
#pragma unroll
    for (int ks = 0; ks < 2; ++ks) { bf16x8 pa[2];
#pragma unroll
        for (int a = 0; a < 2; ++a) { const u32x4 pw = (u32x4){cvt_pk_bf16(s[a][2 * ks][0] * pg[a], s[a][2 * ks][1] * pg[a]), cvt_pk_bf16(s[a][2 * ks][2] * pg[a], s[a][2 * ks][3] * pg[a]),
                                                     cvt_pk_bf16(s[a][2 * ks + 1][0] * pg[a], s[a][2 * ks + 1][1] * pg[a]), cvt_pk_bf16(s[a][2 * ks + 1][2] * pg[a], s[a][2 * ks + 1][3] * pg[a])}; pa[a] = __builtin_bit_cast(bf16x8, pw); }
#pragma unroll
        for (int ne = 0; ne < 8; ne += 2) { bf16x8 v0, v1; const unsigned vb = vbase + 32 * ks * KT_PITCH + 32 * ne; tr_frag2s(vb, vb + 32, 16 * KT_PITCH, v0, v1);
            o[0][ne] = mfma16(pa[0], v0, o[0][ne]); o[1][ne] = mfma16(pa[1], v0, o[1][ne]); o[0][ne + 1] = mfma16(pa[0], v1, o[0][ne + 1]); o[1][ne + 1] = mfma16(pa[1], v1, o[1][ne + 1]); } }
}
template <class MaskF> __device__ __forceinline__ void attn_tile2(const Frame& F, ldsp KT, ldsp VT, f32x4 (&o)[2][8], float (&m)[2], float (&z)[2], float scale2, MaskF mask) {
    const int c = F.lane & 15, g4 = F.lane >> 4; f32x4 s[2][4]; scores2(F, KT, s);
#pragma unroll
    for (int a = 0; a < 2; ++a) { const int q = 8 * F.wave + 4 * a + (c >> 2); float mx = -INFINITY;
#pragma unroll
        for (int nb = 0; nb < 4; ++nb)
#pragma unroll
            for (int j = 0; j < 4; ++j) { const float v = mask(q, 16 * nb + 4 * g4 + j) ? s[a][nb][j] * scale2 : -INFINITY; s[a][nb][j] = v; mx = fmaxf(mx, v); }
        mx = rowgrp_max(mx);
        const float mo = m[a], mn = fmaxf(mo, mx), mu = (mn == -INFINITY) ? 0.f : mn, al = __builtin_amdgcn_exp2f(mo - mu); float rs = 0.f;
#pragma unroll
        for (int nb = 0; nb < 4; ++nb)
#pragma unroll
            for (int j = 0; j < 4; ++j) { const float p = __builtin_amdgcn_exp2f(s[a][nb][j] - mu); s[a][nb][j] = p; rs += p; }
        rs = rowgrp_sum(rs); z[a] = z[a] * al + rs; m[a] = mn;
#pragma unroll
        for (int j = 0; j < 4; ++j) { const float aj = __shfl(al, (F.lane & 48) | (4 * g4 + j));
#pragma unroll
            for (int ne = 0; ne < 8; ++ne) o[a][ne][j] *= aj; } }
    const float one[2] = {1.f, 1.f};
    pv2(F, VT, s, one, o);
}
__device__ __forceinline__ void pl16swap(unsigned& a, unsigned& b) { asm("s_nop 1\n\tv_permlane16_swap_b32 %0, %1" : "+v"(a), "+v"(b)); }
__device__ __forceinline__ void pl32swap(unsigned& a, unsigned& b) { asm("s_nop 1\n\tv_permlane32_swap_b32 %0, %1" : "+v"(a), "+v"(b)); }
__device__ __forceinline__ float xrow_max(float v) { unsigned a = __builtin_bit_cast(unsigned, v), b = a; pl16swap(a, b); const float w = fmaxf(__builtin_bit_cast(float, a), __builtin_bit_cast(float, b));
    a = __builtin_bit_cast(unsigned, w); b = a; pl32swap(a, b); return fmaxf(__builtin_bit_cast(float, a), __builtin_bit_cast(float, b)); }
__device__ __forceinline__ float xrow_sum(float v) { unsigned a = __builtin_bit_cast(unsigned, v), b = a; pl16swap(a, b); const float w = __builtin_bit_cast(float, a) + __builtin_bit_cast(float, b);
    a = __builtin_bit_cast(unsigned, w); b = a; pl32swap(a, b); return __builtin_bit_cast(float, a) + __builtin_bit_cast(float, b); }
template <int KS> __device__ __forceinline__ void rd_qk(unsigned aq, unsigned ak, bf16x8& q0, bf16x8& q1, bf16x8& k0, bf16x8& k1, bf16x8& k2, bf16x8& k3) {
    asm volatile("ds_read_b128 %0, %6 offset:%8\n\tds_read_b128 %1, %6 offset:%9\n\tds_read_b128 %2, %7 offset:%8\n\tds_read_b128 %3, %7 offset:%9\n\tds_read_b128 %4, %7 offset:%10\n\tds_read_b128 %5, %7 offset:%11\n\ts_waitcnt lgkmcnt(0)"
                 : "=&v"(q0), "=&v"(q1), "=&v"(k0), "=&v"(k1), "=&v"(k2), "=&v"(k3) : "v"(aq), "v"(ak), "n"(64 * KS), "n"(16 * KT_PITCH + 64 * KS), "n"(32 * KT_PITCH + 64 * KS), "n"(48 * KT_PITCH + 64 * KS) : "memory");
}
template <int OFF> __device__ __forceinline__ void tr_quad(unsigned vb, bf16x8& r0, bf16x8& r1, bf16x8& r2, bf16x8& r3) {
    s16x4 l0, h0, l1, h1, l2, h2, l3, h3;
    asm volatile("ds_read_b64_tr_b16 %0, %8 offset:%9\n\tds_read_b64_tr_b16 %1, %8 offset:%10\n\tds_read_b64_tr_b16 %2, %8 offset:%11\n\tds_read_b64_tr_b16 %3, %8 offset:%12\n\t"
                 "ds_read_b64_tr_b16 %4, %8 offset:%13\n\tds_read_b64_tr_b16 %5, %8 offset:%14\n\tds_read_b64_tr_b16 %6, %8 offset:%15\n\tds_read_b64_tr_b16 %7, %8 offset:%16\n\ts_waitcnt lgkmcnt(0)"
                 : "=&v"(l0), "=&v"(h0), "=&v"(l1), "=&v"(h1), "=&v"(l2), "=&v"(h2), "=&v"(l3), "=&v"(h3)
                 : "v"(vb), "n"(OFF), "n"(OFF + 16 * KT_PITCH), "n"(OFF + 32), "n"(OFF + 32 + 16 * KT_PITCH), "n"(OFF + 64), "n"(OFF + 64 + 16 * KT_PITCH), "n"(OFF + 96), "n"(OFF + 96 + 16 * KT_PITCH) : "memory");
    r0[0] = l0[0]; r0[1] = l0[1]; r0[2] = l0[2]; r0[3] = l0[3]; r0[4] = h0[0]; r0[5] = h0[1]; r0[6] = h0[2]; r0[7] = h0[3];
    r1[0] = l1[0]; r1[1] = l1[1]; r1[2] = l1[2]; r1[3] = l1[3]; r1[4] = h1[0]; r1[5] = h1[1]; r1[6] = h1[2]; r1[7] = h1[3];
    r2[0] = l2[0]; r2[1] = l2[1]; r2[2] = l2[2]; r2[3] = l2[3]; r2[4] = h2[0]; r2[5] = h2[1]; r2[6] = h2[2]; r2[7] = h2[3];
    r3[0] = l3[0]; r3[1] = l3[1]; r3[2] = l3[2]; r3[3] = l3[3]; r3[4] = h3[0]; r3[5] = h3[1]; r3[6] = h3[2]; r3[7] = h3[3];
}
template <bool A0, bool A1, int MODE> __device__ __forceinline__ void attn_tile3(const Frame& F, ldsp KT, ldsp VT, f32x4 (&o)[2][8], float (&m)[2], float (&z)[2], float scale2, bool rowok0, bool rowok1) {
    const int lane_ = opq(F.lane); const int c = lane_ & 15, g4 = lane_ >> 4; f32x4 s[2][4];
#pragma unroll
    for (int a = 0; a < 2; ++a)
#pragma unroll
        for (int nb = 0; nb < 4; ++nb) s[a][nb] = (f32x4){0.f, 0.f, 0.f, 0.f};
    { const unsigned aq = lds_addr(F.lds + N2_Q + (32 * F.wave + c) * KT_PITCH + 16 * g4), ak = lds_addr(KT + c * KT_PITCH + 16 * g4);
#define T3_KSTEP(KS) do { bf16x8 q0, q1, kf[4]; rd_qk<KS>(aq, ak, q0, q1, kf[0], kf[1], kf[2], kf[3]); _Pragma("unroll") for (int nb = 0; nb < 4; ++nb) { if (A0) s[0][nb] = mfma16(kf[nb], q0, s[0][nb]); if (A1) s[1][nb] = mfma16(kf[nb], q1, s[1][nb]); } } while (0)
      T3_KSTEP(0); T3_KSTEP(1); T3_KSTEP(2); T3_KSTEP(3);
#undef T3_KSTEP
    }
#pragma unroll
    for (int a = 0; a < 2; ++a) { if (!(a ? A1 : A0)) continue;
        const bool rowok = a ? rowok1 : rowok0; const int ql = 8 * F.wave + 4 * a + (c >> 2) - 4 * g4;
        float mx = -INFINITY;
#pragma unroll
        for (int nb = 0; nb < 4; ++nb)
#pragma unroll
            for (int j = 0; j < 4; ++j) { if (MODE == 1) s[a][nb][j] = (16 * nb + j <= ql) ? s[a][nb][j] : -INFINITY; if (MODE == 2) s[a][nb][j] = (16 * nb + j > ql) ? s[a][nb][j] : -INFINITY; mx = fmaxf(mx, s[a][nb][j]); }
        mx = xrow_max(mx); if (!rowok) mx = -INFINITY;
        const float mxs = mx * scale2, mo = m[a]; const bool need = mxs > mo + 8.0f; const float mn = need ? mxs : mo, mu = (mn == -INFINITY) ? 0.f : mn, nmu = rowok ? -mu : -INFINITY; float rs = 0.f;
#pragma unroll
        for (int nb = 0; nb < 4; ++nb)
#pragma unroll
            for (int j = 0; j < 4; ++j) { const float p = __builtin_amdgcn_exp2f(__builtin_fmaf(s[a][nb][j], scale2, nmu)); s[a][nb][j] = p; rs += p; }
        rs = xrow_sum(rs); m[a] = mn;
        if (__ballot(need) != 0ull) { const float al = need ? __builtin_amdgcn_exp2f(mo - mn) : 1.0f; z[a] = z[a] * al + rs;
#pragma unroll
            for (int j = 0; j < 4; ++j) { const float aj = __shfl(al, (lane_ & 48) | (4 * g4 + j));
#pragma unroll
                for (int ne = 0; ne < 8; ++ne) o[a][ne][j] *= aj; } }
        else z[a] += rs; }
    const unsigned vbase = lds_addr(VT) + (unsigned)((4 * g4 + (c >> 2)) * KT_PITCH + (c & 3) * 8);
#pragma unroll
    for (int ks = 0; ks < 2; ++ks) { bf16x8 pa[2];
#pragma unroll
        for (int a = 0; a < 2; ++a) { if (!(a ? A1 : A0)) continue;
            const u32x4 pw = (u32x4){cvt_pk_bf16(s[a][2 * ks][0], s[a][2 * ks][1]), cvt_pk_bf16(s[a][2 * ks][2], s[a][2 * ks][3]), cvt_pk_bf16(s[a][2 * ks + 1][0], s[a][2 * ks + 1][1]), cvt_pk_bf16(s[a][2 * ks + 1][2], s[a][2 * ks + 1][3])}; pa[a] = __builtin_bit_cast(bf16x8, pw); }
#define T3_PV(KS, NE) do { bf16x8 vf[4]; tr_quad<32 * (KS) * KT_PITCH + 32 * (NE)>(vbase, vf[0], vf[1], vf[2], vf[3]); _Pragma("unroll") for (int x = 0; x < 4; ++x) { if (A0) o[0][(NE) + x] = mfma16(pa[0], vf[x], o[0][(NE) + x]); if (A1) o[1][(NE) + x] = mfma16(pa[1], vf[x], o[1][(NE) + x]); } } while (0)
        if (ks == 0) { T3_PV(0, 0); T3_PV(0, 4); } else { T3_PV(1, 0); T3_PV(1, 4); }
#undef T3_PV
    }
}
__device__ __forceinline__ void nsa_attn_phase(const Frame& F0) { PHASE_FRAME(F0);
    const bf16_t* PROJ = (const bf16_t*)(F.ws + WS_PROJ); const bf16_t* KC = (const bf16_t*)(F.ws + WS_KCMP); bf16_t* MIX = (bf16_t*)(F.ws + WS_MIX);
    LAS float* IMP = (LAS float*)(F.lds + N2_IMP); LAS unsigned long long* SEL = (LAS unsigned long long*)(F.lds + N2_SEL); LAS unsigned char* LIST = (LAS unsigned char*)(F.lds + N2_LIST);
    const float scale2 = 0.08838834764831845f * LOG2E;
    const int c = F.lane & 15, g4 = F.lane >> 4;
    for (int k = 0; k * F.G + F.bid < 1024; ++k) {
        F.tid = opq(F.tid); F.lane = F.tid & 63;
        const int c = F.lane & 15, g4 = F.lane >> 4;
        const int ui = k * F.G + F.bid, kk = ui >> 8, bg = ((ui & 7) + 8 * (kk >> 1)) & 15, qx = (ui >> 3) & 31, qb = (kk & 1) ? 63 - qx : qx;
        const int b = bg >> 1, g = bg & 1, start = qb * 64, cur = qb; const size_t row0 = (size_t)b * SEQ + start;
        __syncthreads(); stage_q2(F, PROJ + row0 * LDP + C_NQ + g * 512);
        for (int ii = F.tid; ii < 4096; ii += NTHR) IMP[ii] = 0.f;
        f32x4 o[2][8];
#define N2_ZERO_O() do { _Pragma("unroll") for (int a = 0; a < 2; ++a) _Pragma("unroll") for (int ne = 0; ne < 8; ++ne) o[a][ne] = (f32x4){0.f, 0.f, 0.f, 0.f}; } while (0)
        N2_ZERO_O();
        const bf16_t* gbase = PROJ + row0 * LDP + C_GT;
        bf16_t* const obase = MIX + row0 * DM + g * 512;
        const int ncmp = min(4 * qb + 3, 255), ntile = (ncmp + 63) >> 6;
        const bf16_t* kc = KC + ((size_t)(0 * 8 + b) * 2 + g) * 256 * 128; const bf16_t* vc = KC + ((size_t)(1 * 8 + b) * 2 + g) * 256 * 128;
        float mc[2] = {-INFINITY, -INFINITY}, zc[2] = {0.f, 0.f};
        auto cmp_mask_scale = [&](int ti, f32x4 (&s)[2][4]) {
#pragma unroll
            for (int a = 0; a < 2; ++a) { const int tq = start + 8 * F.wave + 4 * a + (c >> 2);
#pragma unroll
                for (int nb = 0; nb < 4; ++nb)
#pragma unroll
                    for (int j = 0; j < 4; ++j) { const int nn = 64 * ti + 16 * nb + 4 * g4 + j; s[a][nb][j] = (nn <= 254 && 16 * nn + 31 <= tq) ? s[a][nb][j] * scale2 : -INFINITY; } } };
        tile_pipeline<true, false>(F, ntile, 128, 256,
            [&](int ti, const bf16_t*& kp, const bf16_t*& vp, int& pos0) { pos0 = 64 * ti; kp = kc + (size_t)pos0 * 128; vp = kp; },
            [&](int ti, ldsp KT, ldsp VT) { (void)VT; f32x4 s[2][4]; scores2(F, KT, s); cmp_mask_scale(ti, s);
#pragma unroll
                for (int a = 0; a < 2; ++a) { float mx = -INFINITY;
#pragma unroll
                    for (int nb = 0; nb < 4; ++nb)
#pragma unroll
                        for (int j = 0; j < 4; ++j) mx = fmaxf(mx, s[a][nb][j]);
                    mx = rowgrp_max(mx); const float mo = mc[a], mn = fmaxf(mo, mx), mu = (mn == -INFINITY) ? 0.f : mn; float rs = 0.f;
#pragma unroll
                    for (int nb = 0; nb < 4; ++nb)
#pragma unroll
                        for (int j = 0; j < 4; ++j) rs += __builtin_amdgcn_exp2f(s[a][nb][j] - mu);
                    rs = rowgrp_sum(rs); zc[a] = zc[a] * __builtin_amdgcn_exp2f(mo - mu) + rs; mc[a] = mn; } });
        { float gtc[2], mu2[2], inv2[2];
#pragma unroll
          for (int a = 0; a < 2; ++a) { const int c_ = opq(c); const int qc = 8 * F.wave + 4 * a + (c_ >> 2); gtc[a] = sigmoidf_(bf2f(gbase[(unsigned)(qc * LDP + (g * 4 + (c_ & 3)) * 3 + 0)])); mu2[a] = (mc[a] == -INFINITY) ? 0.f : mc[a]; inv2[a] = zc[a] > 0.f ? 1.0f / zc[a] : 0.f; }
          tile_pipeline<true, true>(F, ntile, 128, 256,
            [&](int ti, const bf16_t*& kp, const bf16_t*& vp, int& pos0) { pos0 = 64 * ti; kp = kc + (size_t)pos0 * 128; vp = vc + (size_t)pos0 * 128; },
            [&](int ti, ldsp KT, ldsp VT) { f32x4 s[2][4]; scores2(F, KT, s); cmp_mask_scale(ti, s);
#pragma unroll
                for (int a = 0; a < 2; ++a) { const int qc = 8 * F.wave + 4 * a + (c >> 2);
#pragma unroll
                    for (int nb = 0; nb < 4; ++nb) { float p4 = 0.f;
#pragma unroll
                        for (int j = 0; j < 4; ++j) { const float p = __builtin_amdgcn_exp2f(s[a][nb][j] - mu2[a]) * inv2[a]; s[a][nb][j] = p; p4 += p; }
                        float p3 = s[a][nb][3];
                        p4 += __shfl_xor(p4, 1); p4 += __shfl_xor(p4, 2); p3 += __shfl_xor(p3, 1); p3 += __shfl_xor(p3, 2);
                        const int jj = 16 * ti + 4 * nb + g4;
                        if ((c & 3) == 0 && p4 != 0.f) __hip_atomic_fetch_add(&IMP[qc * 64 + jj], p4, __ATOMIC_RELAXED, __HIP_MEMORY_SCOPE_WORKGROUP);
                        if ((c & 3) == 0 && jj + 1 < 64 && p3 != 0.f) __hip_atomic_fetch_add(&IMP[qc * 64 + jj + 1], p3, __ATOMIC_RELAXED, __HIP_MEMORY_SCOPE_WORKGROUP); } }
                pv2(F, VT, s, gtc, o); }); }
        __syncthreads();
        { LAS unsigned* IMPU = (LAS unsigned*)IMP; const int j = F.lane; const bool valid = j <= cur, forced = (j == 0) || (j == cur) || (j + 1 == cur);
          unsigned myk[8];
#pragma unroll
          for (int qi = 0; qi < 8; ++qi) { const int qq = 8 * F.wave + qi; const unsigned bits = IMPU[qq * 64 + j];
              myk[qi] = !valid ? 0u : (((forced ? 0xFFFFFFC0u : ((bits & ~63u) | 0x80000000u))) | (unsigned)(63 - j)); IMPU[qq * 64 + j] = myk[qi]; }
          LDS_FENCE();
#pragma unroll
          for (int qi = 0; qi < 8; ++qi) { const int qq = 8 * F.wave + qi; int rank = 0;
#pragma unroll
              for (int i4 = 0; i4 < 16; ++i4) { const u32x4 k4 = *(LAS u32x4*)(IMPU + qq * 64 + 4 * i4); rank += (k4.x > myk[qi]) + (k4.y > myk[qi]) + (k4.z > myk[qi]) + (k4.w > myk[qi]); }
              const unsigned long long msk = __ballot(valid && rank < 8);
              if (F.lane == 0) SEL[qq] = msk; } }
        __syncthreads();
        unsigned long long uni = SEL[F.lane];
#pragma unroll
        for (int o_ = 32; o_ >= 1; o_ >>= 1) { const unsigned lo = __shfl_xor((unsigned)uni, o_), hi = __shfl_xor((unsigned)(uni >> 32), o_); uni |= ((unsigned long long)hi << 32) | lo; }
        const unsigned long long U = ((unsigned long long)(unsigned)__builtin_amdgcn_readfirstlane((int)(uni >> 32)) << 32) | (unsigned)__builtin_amdgcn_readfirstlane((int)uni);
        const unsigned long long sel0 = SEL[8 * F.wave + (c >> 2)], sel1 = SEL[8 * F.wave + 4 + (c >> 2)];
        unsigned long long w0 = 0ull, w1 = 0ull;
#pragma unroll
        for (int qi = 0; qi < 4; ++qi) { w0 |= SEL[8 * F.wave + qi]; w1 |= SEL[8 * F.wave + 4 + qi]; }
        const unsigned long long MB0 = ((unsigned long long)(unsigned)__builtin_amdgcn_readfirstlane((int)(w0 >> 32)) << 32) | (unsigned)__builtin_amdgcn_readfirstlane((int)w0);
        const unsigned long long MB1 = ((unsigned long long)(unsigned)__builtin_amdgcn_readfirstlane((int)(w1 >> 32)) << 32) | (unsigned)__builtin_amdgcn_readfirstlane((int)w1);
        int jlist;
        { const int j = F.lane; const bool has = (U >> j) & 1ull; const int r = __popcll(U & ((1ull << j) - 1ull)); const int dst = has ? r : 63 - (j - r);
          jlist = __builtin_amdgcn_ds_permute(dst * 4, j); }
        u32x4* const scr = (u32x4*)(MIX + (size_t)ui * 32768) + (unsigned)(F.wave * 2 * 64 * 4);
        { const int l_ = opq(F.lane);
#pragma unroll
          for (int a = 0; a < 2; ++a)
#pragma unroll
            for (int q4 = 0; q4 < 4; ++q4) { u32x4 w; w.x = pk2(o[a][2 * q4][0], o[a][2 * q4][1]); w.y = pk2(o[a][2 * q4][2], o[a][2 * q4][3]); w.z = pk2(o[a][2 * q4 + 1][0], o[a][2 * q4 + 1][1]); w.w = pk2(o[a][2 * q4 + 1][2], o[a][2 * q4 + 1][3]);
                scr[(a * 64 + l_) * 4 + q4] = w; } }
        float msw[2], zsw[2];
#define N2_FOLD(br, LAST) do { const int l_ = opq(F.lane); const int c = l_ & 15, g4 = l_ >> 4; u32x4 pv_[2][4]; \
            _Pragma("unroll") for (int a = 0; a < 2; ++a) _Pragma("unroll") for (int q4 = 0; q4 < 4; ++q4) pv_[a][q4] = scr[(a * 64 + l_) * 4 + q4]; \
            _Pragma("unroll") for (int a = 0; a < 2; ++a) { const int qr = 8 * F.wave + 4 * a + g4; float w_[4]; \
                _Pragma("unroll") for (int j = 0; j < 4; ++j) { const float zj = __shfl(zsw[a], (l_ & 48) | (4 * g4 + j)); const float gj = sigmoidf_(bf2f(gbase[(unsigned)(qr * LDP + (g * 4 + j) * 3 + (br))])); w_[j] = zj > 0.f ? gj / zj : 0.f; } \
                _Pragma("unroll") for (int q4 = 0; q4 < 4; ++q4) { const unsigned pw_[4] = {pv_[a][q4].x, pv_[a][q4].y, pv_[a][q4].z, pv_[a][q4].w}; float val_[2][4]; \
                    _Pragma("unroll") for (int h = 0; h < 2; ++h) { const int ne = 2 * q4 + h; \
                        val_[h][0] = bflo(pw_[2 * h]) + w_[0] * o[a][ne][0]; val_[h][1] = bfhi(pw_[2 * h]) + w_[1] * o[a][ne][1]; val_[h][2] = bflo(pw_[2 * h + 1]) + w_[2] * o[a][ne][2]; val_[h][3] = bfhi(pw_[2 * h + 1]) + w_[3] * o[a][ne][3]; } \
                    if (LAST) { _Pragma("unroll") for (int h = 0; h < 2; ++h) _Pragma("unroll") for (int j = 0; j < 4; ++j) \
                        ((unsigned char*)(F.ws + WS_MIX8) + row0 * DM + g * 512)[(unsigned)(qr * DM + j * 128 + c) + 16 * (2 * q4 + h)] = f2fp8(val_[h][j] * ACT8_SCALE); } \
                    else { u32x4 w; w.x = pk2(val_[0][0], val_[0][1]); w.y = pk2(val_[0][2], val_[0][3]); w.z = pk2(val_[1][0], val_[1][1]); w.w = pk2(val_[1][2], val_[1][3]); scr[(a * 64 + l_) * 4 + q4] = w; } } } } while (0)
#define N2_RESET() do { msw[0] = msw[1] = -INFINITY; zsw[0] = zsw[1] = 0.f; N2_ZERO_O(); } while (0)
        for (int rep_ = 0; rep_ < PROBE_B2; ++rep_) {
        N2_RESET();
        { const bf16_t* kb = PROJ + (size_t)b * SEQ * LDP + C_NKS + g * 128; const bf16_t* vbp = PROJ + (size_t)b * SEQ * LDP + C_NVS + g * 128;
          tile_pipeline<true, true>(F, __popcll(U), LDP, SEQ,
            [&](int ti, const bf16_t*& kp, const bf16_t*& vp, int& pos0) { const int jb = __builtin_amdgcn_readlane(jlist, ti); pos0 = 64 * jb; kp = kb + (size_t)pos0 * LDP; vp = vbp + (size_t)pos0 * LDP; },
            [&](int ti, ldsp KT, ldsp VT) { const int jb = __builtin_amdgcn_readlane(jlist, ti);
                const bool a0 = (MB0 >> jb) & 1ull, a1 = (MB1 >> jb) & 1ull, r0 = (sel0 >> jb) & 1ull, r1 = (sel1 >> jb) & 1ull;
                if (jb == cur) attn_tile3<true, true, 1>(F, KT, VT, o, msw, zsw, scale2, true, true);
                else if (a0 && a1) attn_tile3<true, true, 0>(F, KT, VT, o, msw, zsw, scale2, r0, r1);
                else if (a0) attn_tile3<true, false, 0>(F, KT, VT, o, msw, zsw, scale2, r0, r1);
                else if (a1) attn_tile3<false, true, 0>(F, KT, VT, o, msw, zsw, scale2, r0, r1); }); }
        }
        N2_FOLD(1, false);
        for (int rep_ = 0; rep_ < PROBE_B3; ++rep_) {
        N2_RESET();
        { const int t0 = cur >= 8 ? cur - 8 : 0, nt = cur - t0 + 1;
          const bf16_t* kb = PROJ + (size_t)b * SEQ * LDP + C_NKW + g * 128; const bf16_t* vbp = PROJ + (size_t)b * SEQ * LDP + C_NVW + g * 128;
          tile_pipeline<true, true>(F, nt, LDP, SEQ,
            [&](int ti, const bf16_t*& kp, const bf16_t*& vp, int& pos0) { pos0 = (t0 + ti) * 64; kp = kb + (size_t)pos0 * LDP; vp = vbp + (size_t)pos0 * LDP; },
            [&](int ti, ldsp KT, ldsp VT) {
                if (ti == nt - 1) attn_tile3<true, true, 1>(F, KT, VT, o, msw, zsw, scale2, true, true);
                else if (cur >= 8 && ti == 0) attn_tile3<true, true, 2>(F, KT, VT, o, msw, zsw, scale2, true, true);
                else attn_tile3<true, true, 0>(F, KT, VT, o, msw, zsw, scale2, true, true); }); }
        }
        N2_FOLD(2, true);
#undef N2_FOLD
#undef N2_RESET
#undef N2_ZERO_O
    }
    __syncthreads();
}
#ifndef STOP
#define STOP 99
#endif
#ifndef PER_PHASE_LAUNCH
#define PER_PHASE_LAUNCH 0
#endif
struct Args { const float* in[25]; float* out; unsigned char* ws; int ph_lo, ph_hi; };
__device__ __forceinline__ void norm_f32_phase(const Frame& F0, const float* src, const float* w, float* dst) { PHASE_FRAME(F0);
    for (int row = F.bid * NWAVE + F.wave; row < MTOK; row += F.G * NWAVE) {
        const float4* p = (const float4*)(src + (size_t)row * DM); float4 v[8]; float ss = 0.f;
#pragma unroll
        for (int i = 0; i < 8; ++i) { v[i] = p[F.lane + 64 * i]; ss += v[i].x * v[i].x + v[i].y * v[i].y + v[i].z * v[i].z + v[i].w * v[i].w; }
        ss = wave_sum(ss); const float rstd = rsqrtf(ss * (1.0f / DM) + RMS_EPS);
#pragma unroll
        for (int i = 0; i < 8; ++i) { const float4 g = ((const float4*)w)[F.lane + 64 * i]; float4 o; o.x = v[i].x * rstd * g.x; o.y = v[i].y * rstd * g.y; o.z = v[i].z * rstd * g.z; o.w = v[i].w * rstd * g.w;
            ((float4*)(dst + (size_t)row * DM))[F.lane + 64 * i] = o; }
    }
}

#if defined(MXTEST)
typedef int v8i_t __attribute__((ext_vector_type(8)));
__device__ __forceinline__ int mx_val(int i, int k) { return ((i * 7 + k * 13 + (i * k) % 5) % 7) - 3; }
__device__ __forceinline__ unsigned mx_fp8(int v) { const unsigned char t[7] = {0xC4, 0xC0, 0xB8, 0x00, 0x38, 0x40, 0x44}; return t[v + 3]; }
__device__ void mx_selftest(float* out) {
    const int lane = threadIdx.x & 63, r = lane & 15, kb = lane >> 4;
    f32x4 ref = (f32x4){0.f, 0.f, 0.f, 0.f};
    for (int ks = 0; ks < 4; ++ks) { bf16x8 a, b;
        for (int j = 0; j < 8; ++j) { const int k = 32 * ks + 8 * kb + j; a[j] = (short)f2bf((float)mx_val(r, k)); b[j] = (short)f2bf((float)mx_val(k, r + 16)); }
        ref = mfma16(a, b, ref); }
    for (int hyp = 0; hyp < 3; ++hyp) {
        v8i_t A, B;
        for (int w = 0; w < 8; ++w) { unsigned wa = 0, wb = 0;
            for (int by = 0; by < 4; ++by) { const int t = 4 * w + by; int k;
                if (hyp == 0) k = 32 * kb + t; else if (hyp == 1) k = (t < 16) ? 16 * kb + t : 64 + 16 * kb + (t - 16); else k = 8 * kb + (t & 7) + 32 * (t >> 3);
                wa |= mx_fp8(mx_val(r, k)) << (8 * by); wb |= mx_fp8(mx_val(k, r + 16)) << (8 * by); }
            A[w] = (int)wa; B[w] = (int)wb; }
        f32x4 acc = (f32x4){0.f, 0.f, 0.f, 0.f};
        acc = __builtin_amdgcn_mfma_scale_f32_16x16x128_f8f6f4(A, B, acc, 0, 0, 0, 0x7f7f7f7f, 0, 0x7f7f7f7f);
        const bool bad = (acc[0] != ref[0]) || (acc[1] != ref[1]) || (acc[2] != ref[2]) || (acc[3] != ref[3]);
        if (__builtin_amdgcn_ballot_w64(bad) != 0ull && lane == 0) out[hyp] = (hyp == 0) ? 1e4f : (hyp == 1) ? 3e4f : 9e4f;
    }
}
#endif
constexpr int N_PHASES = 25;
__global__ void __launch_bounds__(NTHR, 2) fwd_kernel(Args args) {
    extern __shared__ __attribute__((aligned(16))) unsigned char lds_raw[];
    Frame F;
#pragma unroll
    for (int i = 0; i < 25; ++i) F.in[i] = args.in[i];
    F.out = args.out; F.ws = args.ws; F.lds = (ldsp)lds_raw;
    F.tid = threadIdx.x; F.lane = F.tid & 63; F.wave = __builtin_amdgcn_readfirstlane(F.tid >> 6); F.G = gridDim.x; F.bid = blockIdx.x;
    volatile LAS unsigned* misc = (volatile LAS unsigned*)(F.lds + LDS_BYTES - 64);
    for (int i = F.tid; i < LDS_BYTES / 16; i += NTHR) *(LAS u32x4*)(F.lds + 16 * i) = (u32x4){0u, 0u, 0u, 0u};
    __syncthreads();
    XcdBarrier bar; bar.bar = (unsigned*)(F.ws + WS_CTL); bar.x = 0; bar.st = nullptr;
    if (!PER_PHASE_LAUNCH) bar = xcd_barrier_post((unsigned*)(F.ws + WS_CTL), misc);
    const int lo = args.ph_lo, hi = args.ph_hi;
#define IN(k) (lo <= (k) && (k) < hi)
#define SEAM(k) do { if (!PER_PHASE_LAUNCH && IN((k) + 1)) xcd_barrier(bar); } while (0)
    ldsp gl = F.lds;
    bf16_t* HN = (bf16_t*)(F.ws + WS_HN); bf16_t* PROJ = (bf16_t*)(F.ws + WS_PROJ); bf16_t* MIX = (bf16_t*)(F.ws + WS_MIX);

#if defined(DBL_CVT)
    if (IN(0)) { p0_prologue(F); __syncthreads(); p0_prologue(F); SEAM(0); }
#else
    if (IN(0)) { for (int r_ = 0; r_ < PROBE_REP(P0); ++r_) { p0_prologue(F); __syncthreads(); } SEAM(0); }
#endif
#if STOP >= 1
    if (IN(1)) {
        { pg8::Gemm g{HN, (const bf16_t*)(F.ws + WS_WAB_IN), MTOK, IN0_BF, DM}; pg8::StaticOrder S; S.init(MTOK, IN0_BF, F.G, F.bid); pg8::EpiBf16P E{PROJ, LDP, 1.0f};
          pg8::gemm_phase<pg8::EpiBf16P, pg8::StaticOrder, true, true, false, false>(gl, g, S, E); }
        { pg8::Gemm g{(const bf16_t*)(F.ws + WS_HN8), (const bf16_t*)(F.ws + WS_WAB_IN + (size_t)IN0_BF * DM * 2), MTOK, NAB - IN0_BF, DM}; pg8::StaticOrder S; S.init(MTOK, NAB - IN0_BF, F.G, F.bid); pg8::EpiBf16P E{PROJ + IN0_BF, LDP, 0.03125f};
          pg8::gemm_phase<pg8::EpiBf16P, pg8::StaticOrder, true, true, false, true>(gl, g, S, E); }
        SEAM(1); }
#if !defined(PROBE_REP)
#define PROBE_REP(name) 1
#endif
    if (IN(2)) { for (int r_ = 0; r_ < PROBE_REP(HS1); ++r_) hgrn_s1_phase(F); for (int r_ = 0; r_ < PROBE_REP(SWA); ++r_) swa_phase(F); SEAM(2); }
    if (IN(3)) { for (int r_ = 0; r_ < PROBE_REP(HSC); ++r_) hgrn_scan_phase(F); SEAM(3); }
    if (IN(4)) { for (int r_ = 0; r_ < PROBE_REP(HS3); ++r_) hgrn_s3_phase(F); SEAM(4); }
    if (IN(5)) { pg8::Gemm g{OUT_FP8 ? (const bf16_t*)(F.ws + WS_MIX8) : MIX, (const bf16_t*)(F.ws + WS_WAB_OUT), MTOK, DM, DM}; pg8::StaticOrder S; S.init(MTOK, DM, F.G, F.bid); pg8::EpiResBf16<true> E{F.in[0], (bf16_t*)F.out, DM, OUT_FP8 ? ACT8_DESCALE : 1.0f};
        for (int r_ = 0; r_ < PROBE_REP(G5); ++r_) pg8::gemm_phase<pg8::EpiResBf16<true>, pg8::StaticOrder, true, true, false, OUT_FP8>(gl, g, S, E); SEAM(5); }
#endif
#if STOP >= 2
    if (IN(6)) { norm_route_phase(F, 0, F.in[2]); SEAM(8); }
    if (IN(9)) { gather_phase(F, 0); SEAM(9); }
    if (IN(10)) { const int RT = (int)((const unsigned*)(F.ws + WS_CTL))[CW_RT + 0];
        pg8::MoeOrder S; S.initm(RT, F.G, F.bid, (const int*)(F.ws + WS_TEXP));
        if constexpr (MOE_FP8) { pg8::Gemm g{(const bf16_t*)(F.ws + WS_HN8), (const bf16_t*)(F.ws + WS_W1), RT * 256, 2048, DM}; pg8::EpiSwiGLU8 E{(unsigned char*)(F.ws + WS_HID)};
            for (int r_ = 0; r_ < PROBE_REP(G10); ++r_) pg8::gemm_phase<pg8::EpiSwiGLU8, pg8::MoeOrder, true, true, true, true>(gl, g, S, E, (const int*)(F.ws + WS_ROWTOK)); }
        else { pg8::Gemm g{HN, (const bf16_t*)(F.ws + WS_W1), RT * 256, 2048, DM}; pg8::EpiSwiGLU E{(bf16_t*)(F.ws + WS_HID)};
            pg8::gemm_phase<pg8::EpiSwiGLU, pg8::MoeOrder, true, true, true>(gl, g, S, E, (const int*)(F.ws + WS_ROWTOK)); } SEAM(10); }
    if (IN(11)) { const int RT = (int)((const unsigned*)(F.ws + WS_CTL))[CW_RT + 0];
        pg8::Gemm g{(const bf16_t*)(F.ws + WS_HID), (const bf16_t*)(F.ws + WS_W2), RT * 256, 2048, DFF}; pg8::MoeOrder S; S.initm(RT, F.G, F.bid, (const int*)(F.ws + WS_TEXP));
        if constexpr (MOE_FP8) { pg8::EpiMoeDown88 E{(unsigned char*)(F.ws + WS_XS), DM}; for (int r_ = 0; r_ < PROBE_REP(G11); ++r_) pg8::gemm_phase<pg8::EpiMoeDown88, pg8::MoeOrder, true, true, false, true>(gl, g, S, E); }
        else { pg8::EpiMoeDown E{(bf16_t*)(F.ws + WS_XS), DM}; pg8::gemm_phase<pg8::EpiMoeDown, pg8::MoeOrder, true, true>(gl, g, S, E); } SEAM(11); }
#endif
#if STOP >= 3
#if defined(DBL_CVT)
    if (IN(12)) { combine_phase<false>(F, F.in[1] + DM); int rr = 0; convert_moe_layer(F, 1, rr); rr = 0; convert_moe_layer(F, 1, rr); SEAM(12); }
#else
    if (IN(12)) { combine_phase<false>(F, F.in[1] + DM); if (CVT_WG == 0) { for (int r_ = 0; r_ < PROBE_REP(C12); ++r_) { int rr = 0; convert_moe_layer(F, 1, rr); } } SEAM(12); }
#endif
    if (IN(13)) { const int GG = (CVT_WG > 0 && F.G > 2 * CVT_WG) ? F.G - CVT_WG : F.G;
        if (F.bid >= GG) { Frame F2 = F; F2.G = F.G - GG; F2.bid = F.bid - GG; int rr = 0; convert_moe_layer(F2, 1, rr); }
        else {
        pg8::Gemm g{IN1_FP8 ? (const bf16_t*)(F.ws + WS_HN8) : HN, (const bf16_t*)(F.ws + WS_WCD_IN), MTOK, NCD, DM}; pg8::StaticOrder S; S.init(MTOK, NCD, GG, F.bid); pg8::EpiBf16P E{PROJ, LDP, IN1_FP8 ? 0.03125f : 1.0f};
        for (int r_ = 0; r_ < PROBE_REP(G13); ++r_) pg8::gemm_phase<pg8::EpiBf16P, pg8::StaticOrder, true, true, false, IN1_FP8>(gl, g, S, E); }
        if (F.G == GG && CVT_WG > 0) { int rr = 0; convert_moe_layer(F, 1, rr); }
        SEAM(13); }
    if (IN(14)) { for (int r_ = 0; r_ < PROBE_REP(CMP); ++r_) nsa_compress_phase(F); for (int r_ = 0; r_ < PROBE_REP(RS1); ++r_) ret_s1_phase(F); SEAM(14); }
    if (IN(15)) { for (int r_ = 0; r_ < PROBE_REP(RSC); ++r_) ret_scan_phase(F); SEAM(15); }
    if (IN(16)) { for (int r_ = 0; r_ < PROBE_REP(NSA); ++r_) nsa_attn_phase(F); for (int r_ = 0; r_ < PROBE_REP(RS3); ++r_) ret_s3_phase(F); SEAM(16); }
    if (IN(17)) { pg8::Gemm g{OUT_FP8 ? (const bf16_t*)(F.ws + WS_MIX8) : MIX, (const bf16_t*)(F.ws + WS_WCD_OUT), MTOK, DM, DM}; pg8::StaticOrder S; S.init(MTOK, DM, F.G, F.bid); pg8::EpiResBf16<false> E{(const bf16_t*)F.out, (bf16_t*)(F.ws + WS_PROJ), DM, OUT_FP8 ? ACT8_DESCALE : 1.0f};
        pg8::gemm_phase<pg8::EpiResBf16<false>, pg8::StaticOrder, true, true, false, OUT_FP8>(gl, g, S, E);
#if PROBE_G17 > 1
        pg8::gemm_phase<pg8::EpiResBf16<false>, pg8::StaticOrder, true, true, false, OUT_FP8>(gl, g, S, E);
        pg8::gemm_phase<pg8::EpiResBf16<false>, pg8::StaticOrder, true, true, false, OUT_FP8>(gl, g, S, E);
#endif
        SEAM(17); }
#endif
#if STOP >= 4
    if (IN(18)) { norm_route_phase(F, 1, F.in[2] + DM); SEAM(20); }
    if (IN(21)) { gather_phase(F, 1); SEAM(21); }
    if (IN(22)) { const int RT = (int)((const unsigned*)(F.ws + WS_CTL))[CW_RT + 1];
        pg8::MoeOrder S; S.initm(RT, F.G, F.bid, (const int*)(F.ws + WS_TEXP));
        if constexpr (MOE_FP8) { pg8::Gemm g{(const bf16_t*)(F.ws + WS_HN8), (const bf16_t*)(F.ws + WS_W1), RT * 256, 2048, DM}; pg8::EpiSwiGLU8 E{(unsigned char*)(F.ws + WS_HID)};
            pg8::gemm_phase<pg8::EpiSwiGLU8, pg8::MoeOrder, true, true, true, true>(gl, g, S, E, (const int*)(F.ws + WS_ROWTOK)); }
        else { pg8::Gemm g{HN, (const bf16_t*)(F.ws + WS_W1), RT * 256, 2048, DM}; pg8::EpiSwiGLU E{(bf16_t*)(F.ws + WS_HID)};
            pg8::gemm_phase<pg8::EpiSwiGLU, pg8::MoeOrder, true, true, true>(gl, g, S, E, (const int*)(F.ws + WS_ROWTOK)); } SEAM(22); }
    if (IN(23)) { const int RT = (int)((const unsigned*)(F.ws + WS_CTL))[CW_RT + 1];
        pg8::Gemm g{(const bf16_t*)(F.ws + WS_HID), (const bf16_t*)(F.ws + WS_W2), RT * 256, 2048, DFF}; pg8::MoeOrder S; S.initm(RT, F.G, F.bid, (const int*)(F.ws + WS_TEXP));
        if constexpr (MOE_FP8) { pg8::EpiMoeDown88 E{(unsigned char*)(F.ws + WS_XS), DM}; pg8::gemm_phase<pg8::EpiMoeDown88, pg8::MoeOrder, true, true, false, true>(gl, g, S, E); }
        else { pg8::EpiMoeDown E{(bf16_t*)(F.ws + WS_XS), DM}; pg8::gemm_phase<pg8::EpiMoeDown, pg8::MoeOrder, true, true>(gl, g, S, E); } SEAM(23); }
#endif
#if defined(MXTEST)
    if (IN(24) && F.bid == 0 && F.tid < 64) { __builtin_amdgcn_s_sleep(1); }
#endif
    if (IN(24)) {
#if STOP == 0
        norm_f32_phase(F, F.in[0], F.in[3], F.out);
#elif STOP == 1 || STOP == 3
        norm_f32_phase(F, F.out, F.in[3], F.out);
#else
        for (int r_ = 0; r_ < PROBE_REP(CMB); ++r_) combine_phase<true>(F, F.in[3]);
#endif
    }
#if defined(MXTEST)
    __syncthreads();
    if (hi == N_PHASES) { xcd_barrier(bar); if (F.bid == 0 && F.tid < 64) mx_selftest(F.out); }
#endif
#undef IN
#undef SEAM
}


#if defined(DETCHK)
__global__ void checksum_kernel(const unsigned* p, size_t nwords, unsigned long long* dst) {
    unsigned long long s = 0; for (size_t i = (size_t)blockIdx.x * blockDim.x + threadIdx.x; i < nwords; i += (size_t)gridDim.x * blockDim.x) s += (unsigned long long)p[i] * (unsigned long long)((i & 1023) + 1);
    for (int o = 32; o >= 1; o >>= 1) s += __shfl_xor(s, o);
    if ((threadIdx.x & 63) == 0) atomicAdd(dst, s);
}
__global__ void compare_kernel(const unsigned long long* cs, int n, float* out) {
    if (threadIdx.x == 0 && blockIdx.x == 0) { for (int k = 0; k < n; ++k) if (cs[k] != cs[32 + k]) { float v = 1e4f; for (int i = 0; i < k; ++i) v *= 3.1622776f; out[0] = v; break; } }
}
__global__ void checksum2d_kernel(const unsigned* p, int rows, int pitchw, int c0w, int ncw, unsigned long long* dst) {
    unsigned long long s = 0; const size_t n = (size_t)rows * ncw;
    for (size_t i = (size_t)blockIdx.x * blockDim.x + threadIdx.x; i < n; i += (size_t)gridDim.x * blockDim.x) { const size_t r = i / ncw, c = i % ncw; s += (unsigned long long)p[r * pitchw + c0w + c] * (unsigned long long)((i & 1023) + 1); }
    for (int o = 32; o >= 1; o >>= 1) s += __shfl_xor(s, o);
    if ((threadIdx.x & 63) == 0) atomicAdd(dst, s);
}
__global__ void checksum_rowsel_kernel(const unsigned* p, int rows, int pitchw, int c0w, int ncw, int want_n0, unsigned long long* dst) {
    unsigned long long s = 0; const size_t n = (size_t)rows * ncw;
    for (size_t i = (size_t)blockIdx.x * blockDim.x + threadIdx.x; i < n; i += (size_t)gridDim.x * blockDim.x) { const size_t r = i / ncw, c = i % ncw; const bool n0 = ((r >> 7) & 31) == 0;
        if (n0 == (want_n0 != 0)) s += (unsigned long long)p[r * pitchw + c0w + c] * (unsigned long long)((i & 1023) + 1); }
    for (int o = 32; o >= 1; o >>= 1) s += __shfl_xor(s, o);
    if ((threadIdx.x & 63) == 0) atomicAdd(dst, s);
}
__global__ void compare2_kernel(const unsigned long long* cs, float* out) {
    if (threadIdx.x == 0 && blockIdx.x == 0) { if (cs[20] != cs[21] || cs[52] != cs[53]) out[0] = 1e4f; if (cs[21] != cs[53]) out[1] = 3e4f; if (cs[22] != cs[23] || cs[54] != cs[55] || cs[23] != cs[55]) out[2] = 9e4f; }
}
struct Chk { int after_phase; size_t off; size_t bytes; int in_out; };
#endif
extern "C" void kernel_launch(void* const* d_in, const int* in_sizes, int n_in, void* d_out, int out_size, void* d_ws, size_t ws_size, hipStream_t stream) {
    static int grid = 0;
    if (grid == 0) {
        if (n_in != 25 || out_size != MTOK * DM || ws_size < WS_END) { fprintf(stderr, "kernel_launch: unexpected shapes (n_in %d out %d ws %zu need %zu)\n", n_in, out_size, ws_size, (size_t)WS_END); grid = -1; return; }
        int dev = 0, cus = 0, per_cu = 0;
        if (hipGetDevice(&dev) != hipSuccess || hipDeviceGetAttribute(&cus, hipDeviceAttributeMultiprocessorCount, dev) != hipSuccess) { grid = -1; return; }
        if (hipFuncSetAttribute((const void*)fwd_kernel, hipFuncAttributeMaxDynamicSharedMemorySize, LDS_BYTES) != hipSuccess) { fprintf(stderr, "kernel_launch: hipFuncSetAttribute failed\n"); grid = -1; return; }
        if (hipOccupancyMaxActiveBlocksPerMultiprocessor(&per_cu, (const void*)fwd_kernel, NTHR, LDS_BYTES) != hipSuccess || per_cu < 1) { fprintf(stderr, "kernel_launch: occupancy query says %d\n", per_cu); (void)hipGetLastError(); grid = -1; return; }
        grid = cus;
    }
    if (grid < 0) return;
    (void)hipMemsetAsync((char*)d_ws + WS_CTL, 0, CTL_BYTES, stream);
    Args a{};
    for (int i = 0; i < 25; ++i) a.in[i] = (const float*)d_in[i];
    a.out = (float*)d_out; a.ws = (unsigned char*)d_ws;
#if PER_PHASE_LAUNCH && defined(DETCHK)
    static const Chk chks[] = { {0, WS_HN, (size_t)MTOK * DM * 2, 0}, {2, WS_DS, (size_t)4096 * 16384 * 4, 0}, {3, WS_SPREV, (size_t)4096 * 16384 * 2, 0}, {4, WS_MIX, (size_t)MTOK * DM * 2, 0},
        {5, 0, (size_t)MTOK * DM * 4, 1}, {7, WS_LOG, (size_t)MTOK * 256 * 4, 0}, {8, WS_RTE, (size_t)MTOK * 16, 0}, {12, 0, (size_t)MTOK * DM * 4, 1}, {13, WS_PROJ, (size_t)MTOK * LDP * 2, 0},
        {14, WS_KCMP, (size_t)2 * 8 * 2 * 256 * 128 * 2, 0}, {15, WS_RPREV, (size_t)1024 * 32768 * 2, 0}, {16, WS_MIX, 1, 2}, {16, WS_MIX, 2, 2}, {17, 0, (size_t)MTOK * DM * 4, 1}, {19, WS_LOG, (size_t)MTOK * 256 * 4, 0}, {20, WS_RTE, (size_t)MTOK * 16, 0}, {24, 0, (size_t)MTOK * DM * 4, 1} };
    const int nchk = (int)(sizeof(chks) / sizeof(chks[0]));
    unsigned long long* cs = (unsigned long long*)((char*)d_ws + WS_CTL + 32768);
    (void)hipMemsetAsync((char*)d_ws + CTL_BYTES, 0xAA, ws_size - CTL_BYTES, stream);
    (void)hipMemsetAsync(d_out, 0xAA, (size_t)MTOK * DM * 4, stream);
    for (int run = 0; run < 2; ++run) {
        if (run == 1) (void)hipMemsetAsync((char*)d_ws + WS_CTL + 16384, 0, 2048, stream);
        for (int ph = 0; ph < N_PHASES; ++ph) { a.ph_lo = ph; a.ph_hi = ph + 1; hipLaunchKernelGGL(fwd_kernel, dim3(grid), dim3(NTHR), LDS_BYTES, stream, a);
            if (ph == 16) { hipLaunchKernelGGL(checksum2d_kernel, dim3(1024), dim3(256), 0, stream, (const unsigned*)((char*)d_ws + WS_MIX), MTOK, 1024, 512, 512, cs + run * 32 + 20);
                hipLaunchKernelGGL(checksum2d_kernel, dim3(1024), dim3(256), 0, stream, (const unsigned*)((char*)d_ws + WS_MIX), MTOK, 1024, 0, 512, cs + run * 32 + 22);
                hipLaunchKernelGGL(fwd_kernel, dim3(grid), dim3(NTHR), LDS_BYTES, stream, a);
                hipLaunchKernelGGL(checksum2d_kernel, dim3(1024), dim3(256), 0, stream, (const unsigned*)((char*)d_ws + WS_MIX), MTOK, 1024, 512, 512, cs + run * 32 + 21);
                hipLaunchKernelGGL(checksum2d_kernel, dim3(1024), dim3(256), 0, stream, (const unsigned*)((char*)d_ws + WS_MIX), MTOK, 1024, 0, 512, cs + run * 32 + 23); }
            for (int k = 0; k < nchk; ++k) if (chks[k].after_phase == ph) { if (chks[k].in_out == 2) { hipLaunchKernelGGL(checksum2d_kernel, dim3(1024), dim3(256), 0, stream, (const unsigned*)((char*)d_ws + WS_MIX), MTOK, 1024, chks[k].bytes == 1 ? 0 : 512, 512, cs + run * 32 + k); continue; } const unsigned* p = chks[k].in_out ? (const unsigned*)d_out : (const unsigned*)((char*)d_ws + chks[k].off);
                hipLaunchKernelGGL(checksum_kernel, dim3(1024), dim3(256), 0, stream, p, chks[k].bytes / 4, cs + run * 32 + k); } }
    }
    hipLaunchKernelGGL(compare2_kernel, dim3(1), dim3(64), 0, stream, (const unsigned long long*)cs, (float*)d_out);
#elif PER_PHASE_LAUNCH
    for (int ph = 0; ph < N_PHASES; ++ph) { a.ph_lo = ph; a.ph_hi = ph + 1; hipLaunchKernelGGL(fwd_kernel, dim3(grid), dim3(NTHR), LDS_BYTES, stream, a); }
#else
    a.ph_lo = 0; a.ph_hi = N_PHASES;
    hipLaunchKernelGGL(fwd_kernel, dim3(grid), dim3(NTHR), LDS_BYTES, stream, a);
#endif
}
```

```cpp
#include <hip/hip_runtime.h>
#include <cstdio>
#include <cstdint>
#define IN0_BF_COLS 2048

#define XB_TMO      128
#define XB_XCNT(j)  (256  + 64 * (j))
#define XB_XSUB(j)  (1280 + 64 * (j))
#define XB_XGEN(j)  (2304 + 64 * (j))
#define XB_TOP      3328
#define XB_TOPGEN   3392
#define XCD_BAR_WORDS 3456
#define XB_SPIN_CAP (1u << 18)
#define LAS __attribute__((address_space(3)))

__device__ __forceinline__ unsigned xb_ld(unsigned* p)              { return __hip_atomic_load(p, __ATOMIC_RELAXED, __HIP_MEMORY_SCOPE_AGENT); }
__device__ __forceinline__ unsigned xb_add(unsigned* p, unsigned v) { return __hip_atomic_fetch_add(p, v, __ATOMIC_RELAXED, __HIP_MEMORY_SCOPE_AGENT); }
__device__ __forceinline__ unsigned xb_xcc_id() { return (unsigned)__builtin_amdgcn_s_getreg((3 << 11) | 20) & 0xFu; }
#define XB_SPIN(cond, bar) do { unsigned _sp = 0; while (cond) { __builtin_amdgcn_s_sleep(1); \
    if ((++_sp & 255u) == 0u) { if (xb_ld(&(bar)[XB_TMO])) break; if (_sp > XB_SPIN_CAP) { atomicAdd(&(bar)[XB_TMO], 1u); break; } } } } while (0)

struct XcdBarrier {
    unsigned* bar; unsigned x;
    volatile LAS unsigned* st;
};

__device__ __forceinline__ XcdBarrier xcd_barrier_post(unsigned* bar, volatile LAS unsigned* st) {
    XcdBarrier b; b.bar = bar; b.x = xb_xcc_id(); b.st = st;
    if (threadIdx.x == 0) (void)xb_add(&bar[XB_XCNT(b.x)], 1u);
    return b;
}
__device__ __forceinline__ void xcd_barrier_complete(unsigned* bar, unsigned x, unsigned& nloc, unsigned& nx) {
    const unsigned G = gridDim.x * gridDim.y * gridDim.z;
    unsigned sum, cnt, mine, sp = 0u;
    for (;;) {
        sum = 0u; cnt = 0u; mine = 0u;
#pragma unroll
        for (unsigned j = 0; j < 16; ++j) { const unsigned c = xb_ld(&bar[XB_XCNT(j)]); sum += c; cnt += (c > 0u) ? 1u : 0u; mine = (j == x) ? c : mine; }
        if (sum == G) break;
        __builtin_amdgcn_s_sleep(1);
        if ((++sp & 255u) == 0u) { if (xb_ld(&bar[XB_TMO])) break; if (sp > XB_SPIN_CAP) { atomicAdd(&bar[XB_TMO], 1u); break; } }
    }
    nloc = mine > 0u ? mine : 1u; nx = cnt > 0u ? cnt : 1u;
}

__device__ __forceinline__ void xcd_barrier(const XcdBarrier& b) {
    asm volatile("s_waitcnt vmcnt(0)" ::: "memory");
    __syncthreads();
    if (threadIdx.x == 0) {
        unsigned* bar = b.bar;
        __builtin_amdgcn_s_waitcnt(0);
        unsigned nloc = b.st[0], nx = b.st[1];
        if (nloc == 0u) { xcd_barrier_complete(bar, b.x, nloc, nx); b.st[0] = nloc; b.st[1] = nx; }
        const unsigned old = xb_add(&bar[XB_XSUB(b.x)], 1u);
        const unsigned gen = old / nloc;
        if (old + 1u == (gen + 1u) * nloc) {
            __builtin_amdgcn_fence(__ATOMIC_RELEASE, "agent");
            asm volatile("s_waitcnt vmcnt(0)" ::: "memory");
            const unsigned og = xb_add(&bar[XB_TOP], 1u);
            const unsigned tg = og / nx;
            if (og + 1u == (tg + 1u) * nx) xb_add(&bar[XB_TOPGEN], 1u);
            else XB_SPIN(xb_ld(&bar[XB_TOPGEN]) == tg, bar);
            __builtin_amdgcn_fence(__ATOMIC_ACQUIRE, "agent");
            xb_add(&bar[XB_XGEN(b.x)], 1u);
            asm volatile("s_waitcnt vmcnt(0)" ::: "memory");
        } else {
            XB_SPIN(xb_ld(&bar[XB_XGEN(b.x)]) == gen, bar);
            __builtin_amdgcn_fence(__ATOMIC_ACQUIRE, "agent");
            asm volatile("s_waitcnt vmcnt(0)" ::: "memory");
        }
    }
    __syncthreads();
}

namespace pg8 {
#define PG8_LAS __attribute__((address_space(3)))
typedef unsigned short bf16_t;
typedef short bf16x8 __attribute__((ext_vector_type(8)));
typedef float f32x4 __attribute__((ext_vector_type(4)));
typedef unsigned u32x4 __attribute__((ext_vector_type(4)));
constexpr int BM = 256, BK = 64, HALF = 128, HTB = HALF * BK * 2  , STAGE_BYTES = 8 * HTB, NXCD = 8, WGM = 8;

__host__ __device__ __forceinline__ int lds_byte(int r, int c) { const int st = (r >> 4) * 2 + (c >> 5), rr = r & 15, cc = c & 31, ob = rr * 64 + cc * 2; return st * 1024 + (ob ^ (((ob >> 9) & 1) << 5)); }
__host__ __device__ __forceinline__ void stage_rc(int b, int& R, int& C) { const int st = b / 1024, sb = b % 1024, swz = sb ^ (((sb >> 9) & 1) << 5); R = (st >> 1) * 16 + swz / 64; C = (st & 1) * 32 + (swz % 64) / 2; }
__host__ __device__ __forceinline__ int perm32(int rho) { const int n = rho >> 4, i = rho & 15; return 8 * (i >> 2) + 4 * n + (i & 3); }

struct Unit { int pm, pn; };
struct Gemm { const bf16_t* A; const bf16_t* Bt; int M, N, K; };

struct StaticOrder {
    int nM, nN, nwg, G, c;
    __host__ __device__ void init(int M, int N, int G_, int c_) { nM = M / BM; nN = N / BM; nwg = nM * nN; G = G_; c = c_; }
    __host__ __device__ bool next(int i, Unit& u) const {
        const long L = (long)i * G + c; if (L >= nwg) return false;
        int wgid = (int)L; { const int q = nwg / NXCD, r = nwg % NXCD, xcd = wgid % NXCD, off = wgid / NXCD; wgid = (xcd < r ? xcd * (q + 1) : r * (q + 1) + (xcd - r) * q) + off; }
        const int nig = WGM * nN, gid = wgid / nig, fm = gid * WGM, gsz = (nM - fm) < WGM ? (nM - fm) : WGM;
        u.pm = fm + ((wgid % nig) % gsz); u.pn = (wgid % nig) / gsz; return true;
    }
    __device__ __forceinline__ void a_ready(const Unit&) const {}
    __device__ __forceinline__ void done(const Unit&) const {}
};

typedef float f32x2c __attribute__((ext_vector_type(2))); typedef __bf16 bf16x2c __attribute__((ext_vector_type(2)));
__device__ __forceinline__ unsigned cvt_pk_bf16(float lo, float hi) { const f32x2c v = {lo, hi}; return __builtin_bit_cast(unsigned, __builtin_convertvector(v, bf16x2c)); }
typedef float f32x2 __attribute__((ext_vector_type(2)));
struct EpiBf16P {
    static constexpr bool PERM = true, AFTER_DRAIN = false;
    bf16_t* O; int ldc; float sc;
    __device__ __forceinline__ void operator()(const f32x4 (&acc)[2][2][4][2], const Unit& u, int wr, int wc, int fr, int fq) const {
        const int row0 = u.pm * BM + wr * 64 + fr, col0 = u.pn * BM + wc * 32 + 8 * fq;
#pragma unroll
        for (int ai = 0; ai < 2; ++ai)
#pragma unroll
            for (int m = 0; m < 4; ++m) { bf16_t* rowp = O + (size_t)(row0 + ai * HALF + m * 16) * ldc + col0;
#pragma unroll
                for (int bj = 0; bj < 2; ++bj) { const f32x4 v0 = acc[ai][bj][m][0] * sc, v1 = acc[ai][bj][m][1] * sc;
                    u32x4 w; w.x = cvt_pk_bf16(v0[0], v0[1]); w.y = cvt_pk_bf16(v0[2], v0[3]); w.z = cvt_pk_bf16(v1[0], v1[1]); w.w = cvt_pk_bf16(v1[2], v1[3]);
                    *(u32x4*)(rowp + bj * HALF) = w; } }
    }
};
struct EpiMoeDown {
    static constexpr bool PERM = true, AFTER_DRAIN = false;
    bf16_t* O; int ldc;
    __device__ __forceinline__ void operator()(const f32x4 (&acc)[2][2][4][2], const Unit& u, int wr, int wc, int fr, int fq) const {
        const int row0 = u.pm * BM + wr * 64 + fr, col0 = (u.pn & 7) * BM + wc * 32 + 8 * fq;
#pragma unroll
        for (int ai = 0; ai < 2; ++ai)
#pragma unroll
            for (int m = 0; m < 4; ++m) { bf16_t* rowp = O + (size_t)(row0 + ai * HALF + m * 16) * ldc + col0;
#pragma unroll
                for (int bj = 0; bj < 2; ++bj) { const f32x4 v0 = acc[ai][bj][m][0], v1 = acc[ai][bj][m][1];
                    u32x4 w; w.x = cvt_pk_bf16(v0[0], v0[1]); w.y = cvt_pk_bf16(v0[2], v0[3]); w.z = cvt_pk_bf16(v1[0], v1[1]); w.w = cvt_pk_bf16(v1[2], v1[3]);
                    *(u32x4*)(rowp + bj * HALF) = w; } }
    }
};
typedef unsigned u32x2 __attribute__((ext_vector_type(2)));
__device__ __forceinline__ unsigned pk_fp8x4(float a, float b, float c_, float d) { int r = 0; r = __builtin_amdgcn_cvt_pk_fp8_f32(a, b, r, false); r = __builtin_amdgcn_cvt_pk_fp8_f32(c_, d, r, true); return (unsigned)r; }
struct EpiSwiGLU8 {
    static constexpr bool PERM = true, AFTER_DRAIN = false;
    unsigned char* O;
    __device__ __forceinline__ void operator()(const f32x4 (&acc)[2][2][4][2], const Unit& u, int wr, int wc, int fr, int fq) const {
        const int row0 = u.pm * BM + wr * 64 + fr, col0 = (u.pn & 7) * 128 + wc * 32 + 8 * fq;
#pragma unroll
        for (int ai = 0; ai < 2; ++ai)
#pragma unroll
            for (int m = 0; m < 4; ++m) { unsigned char* rowp = O + (size_t)(row0 + ai * HALF + m * 16) * 1024 + col0;
                float h[8];
#pragma unroll
                for (int n = 0; n < 2; ++n)
#pragma unroll
                    for (int j = 0; j < 4; ++j) { const float g = acc[ai][0][m][n][j] * 0.03125f, up = acc[ai][1][m][n][j] * 0.03125f; h[n * 4 + j] = g * __builtin_amdgcn_rcpf(1.0f + __expf(-g)) * up; }
                u32x2 w; w.x = pk_fp8x4(8.f * h[0], 8.f * h[1], 8.f * h[2], 8.f * h[3]); w.y = pk_fp8x4(8.f * h[4], 8.f * h[5], 8.f * h[6], 8.f * h[7]);
                *(u32x2*)rowp = w; }
    }
};
struct EpiMoeDown8 {
    static constexpr bool PERM = true, AFTER_DRAIN = false;
    bf16_t* O; int ldc;
    __device__ __forceinline__ void operator()(const f32x4 (&acc)[2][2][4][2], const Unit& u, int wr, int wc, int fr, int fq) const {
        const int row0 = u.pm * BM + wr * 64 + fr, col0 = (u.pn & 7) * BM + wc * 32 + 8 * fq;
#pragma unroll
        for (int ai = 0; ai < 2; ++ai)
#pragma unroll
            for (int m = 0; m < 4; ++m) { bf16_t* rowp = O + (size_t)(row0 + ai * HALF + m * 16) * ldc + col0;
#pragma unroll
                for (int bj = 0; bj < 2; ++bj) { const f32x4 v0 = acc[ai][bj][m][0] * (0.03125f / 8.0f), v1 = acc[ai][bj][m][1] * (0.03125f / 8.0f);
                    u32x4 w; w.x = cvt_pk_bf16(v0[0], v0[1]); w.y = cvt_pk_bf16(v0[2], v0[3]); w.z = cvt_pk_bf16(v1[0], v1[1]); w.w = cvt_pk_bf16(v1[2], v1[3]);
                    *(u32x4*)(rowp + bj * HALF) = w; } }
    }
};
struct EpiMoeDown88 {
    static constexpr bool PERM = true, AFTER_DRAIN = false;
    unsigned char* O; int ldc;
    __device__ __forceinline__ void operator()(const f32x4 (&acc)[2][2][4][2], const Unit& u, int wr, int wc, int fr, int fq) const {
        const int row0 = u.pm * BM + wr * 64 + fr, col0 = (u.pn & 7) * BM + wc * 32 + 8 * fq;
#pragma unroll
        for (int ai = 0; ai < 2; ++ai)
#pragma unroll
            for (int m = 0; m < 4; ++m) { unsigned char* rowp = O + (size_t)(row0 + ai * HALF + m * 16) * ldc + col0;
#pragma unroll
                for (int bj = 0; bj < 2; ++bj) { const f32x4 v0 = acc[ai][bj][m][0] * 0.0625f, v1 = acc[ai][bj][m][1] * 0.0625f;
                    u32x2 w; w.x = pk_fp8x4(v0[0], v0[1], v0[2], v0[3]); w.y = pk_fp8x4(v1[0], v1[1], v1[2], v1[3]);
                    *(u32x2*)(rowp + bj * HALF) = w; } }
    }
};
struct EpiSwiGLU {
    static constexpr bool PERM = true, AFTER_DRAIN = false;
    bf16_t* O;
    __device__ __forceinline__ void operator()(const f32x4 (&acc)[2][2][4][2], const Unit& u, int wr, int wc, int fr, int fq) const {
        const int row0 = u.pm * BM + wr * 64 + fr, col0 = (u.pn & 7) * 128 + wc * 32 + 8 * fq;
#pragma unroll
        for (int ai = 0; ai < 2; ++ai)
#pragma unroll
            for (int m = 0; m < 4; ++m) { bf16_t* rowp = O + (size_t)(row0 + ai * HALF + m * 16) * 1024 + col0;
                float h[8];
#pragma unroll
                for (int n = 0; n < 2; ++n)
#pragma unroll
                    for (int j = 0; j < 4; ++j) { const float g = acc[ai][0][m][n][j], up = acc[ai][1][m][n][j]; h[n * 4 + j] = g * __builtin_amdgcn_rcpf(1.0f + __expf(-g)) * up; }
                u32x4 w; w.x = cvt_pk_bf16(h[0], h[1]); w.y = cvt_pk_bf16(h[2], h[3]); w.z = cvt_pk_bf16(h[4], h[5]); w.w = cvt_pk_bf16(h[6], h[7]);
                *(u32x4*)rowp = w; }
    }
};
struct EpiResF32 {
    static constexpr bool PERM = false, AFTER_DRAIN = false;
    const float* R; float* C; int ldc; float sc;
    __device__ __forceinline__ void operator()(const f32x4 (&acc)[2][2][4][2], const Unit& u, int wr, int wc, int fr, int fq) const {
        const int row0 = u.pm * BM + wr * 64 + fr, col0 = u.pn * BM + wc * 32 + 4 * fq;
#pragma unroll
        for (int ai = 0; ai < 2; ++ai)
#pragma unroll
            for (int m = 0; m < 4; ++m) { const size_t ro = (size_t)(row0 + ai * HALF + m * 16) * ldc + col0; f32x4 r[2][2];
#pragma unroll
                for (int bj = 0; bj < 2; ++bj)
#pragma unroll
                    for (int n = 0; n < 2; ++n) r[bj][n] = *(const f32x4*)(R + ro + bj * HALF + n * 16);
#pragma unroll
                for (int bj = 0; bj < 2; ++bj)
#pragma unroll
                    for (int n = 0; n < 2; ++n) *(f32x4*)(C + ro + bj * HALF + n * 16) = acc[ai][bj][m][n] * sc + r[bj][n]; }
    }
};
template <bool RF32> struct EpiResBf16 {
    static constexpr bool PERM = true, AFTER_DRAIN = false;
    const void* R; bf16_t* C; int ldc; float sc;
    __device__ __forceinline__ void operator()(const f32x4 (&acc)[2][2][4][2], const Unit& u, int wr, int wc, int fr, int fq) const {
        const int row0 = u.pm * BM + wr * 64 + fr, col0 = u.pn * BM + wc * 32 + 8 * fq;
#pragma unroll
        for (int ai = 0; ai < 2; ++ai) {
            f32x4 rf[4][2][2]; u32x4 rb[4][2];
#pragma unroll
            for (int m = 0; m < 4; ++m) { const size_t ro = (size_t)(row0 + ai * HALF + m * 16) * ldc + col0;
#pragma unroll
                for (int bj = 0; bj < 2; ++bj) {
                    if (RF32) { rf[m][bj][0] = __builtin_nontemporal_load((const f32x4*)((const float*)R + ro + bj * HALF)); rf[m][bj][1] = __builtin_nontemporal_load((const f32x4*)((const float*)R + ro + bj * HALF + 4)); }
                    else rb[m][bj] = *(const u32x4*)((const bf16_t*)R + ro + bj * HALF); } }
#pragma unroll
            for (int m = 0; m < 4; ++m) { const size_t ro = (size_t)(row0 + ai * HALF + m * 16) * ldc + col0;
#pragma unroll
                for (int bj = 0; bj < 2; ++bj) { f32x4 r0, r1;
                    if (RF32) { r0 = rf[m][bj][0]; r1 = rf[m][bj][1]; }
                    else { const u32x4 b = rb[m][bj];
                        r0 = (f32x4){__builtin_bit_cast(float, b.x << 16), __builtin_bit_cast(float, b.x & 0xffff0000u), __builtin_bit_cast(float, b.y << 16), __builtin_bit_cast(float, b.y & 0xffff0000u)};
                        r1 = (f32x4){__builtin_bit_cast(float, b.z << 16), __builtin_bit_cast(float, b.z & 0xffff0000u), __builtin_bit_cast(float, b.w << 16), __builtin_bit_cast(float, b.w & 0xffff0000u)}; }
                    const f32x4 v0 = acc[ai][bj][m][0] * sc + r0, v1 = acc[ai][bj][m][1] * sc + r1;
                    u32x4 w; w.x = cvt_pk_bf16(v0[0], v0[1]); w.y = cvt_pk_bf16(v0[2], v0[3]); w.z = cvt_pk_bf16(v1[0], v1[1]); w.w = cvt_pk_bf16(v1[2], v1[3]);
                    *(u32x4*)(C + ro + bj * HALF) = w; } } }
    }
};
struct EpiF32P {
    static constexpr bool PERM = false, AFTER_DRAIN = false;
    float* C; int ldc;
    __device__ __forceinline__ void operator()(const f32x4 (&acc)[2][2][4][2], const Unit& u, int wr, int wc, int fr, int fq) const {
        const int row0 = u.pm * BM + wr * 64 + fr, col0 = u.pn * BM + wc * 32 + 4 * fq;
#pragma unroll
        for (int ai = 0; ai < 2; ++ai)
#pragma unroll
            for (int m = 0; m < 4; ++m) { const size_t ro = (size_t)(row0 + ai * HALF + m * 16) * ldc + col0;
#pragma unroll
                for (int bj = 0; bj < 2; ++bj)
#pragma unroll
                    for (int n = 0; n < 2; ++n) *(f32x4*)(C + ro + bj * HALF + n * 16) = acc[ai][bj][m][n]; }
    }
};
struct MoeOrder : StaticOrder {
    const int* tile_exp;
    __device__ void initm(int RT, int G_, int c_, const int* te) { nM = RT; nN = 8; nwg = nM * nN; G = G_; c = c_; tile_exp = te; }
    __device__ bool next(int i, Unit& u) const {
        if (!StaticOrder::next(i, u)) return false;
        const int e = __builtin_amdgcn_readfirstlane(tile_exp[u.pm]);
        u.pn = e * 8 + u.pn; return true;
    }
};
template <class Epi, class Sched, bool ALIGN_EPI = false, bool SP2 = false, bool GATHER = false, bool FP8 = false>
__device__ __forceinline__ void gemm_phase(PG8_LAS unsigned char* lds, const Gemm g, const Sched& S, const Epi& E, const int* rowmap = nullptr) {
    const int tid = threadIdx.x, wid = __builtin_amdgcn_readfirstlane(tid >> 6), lane = tid & 63, wr = wid >> 2, wc = wid & 3, fr = lane & 15, fq = lane >> 4;
    const int K = g.K, Kb = FP8 ? K : 2 * K  , nt = Kb / (2 * BK);
    unsigned voffA[2], voffB[2];
#pragma unroll
    for (int i = 0; i < 2; ++i) { int R, C; stage_rc(tid * 16 + i * 8192, R, C); const int Rb = Epi::PERM ? ((R & ~31) + perm32(R & 31)) : R;
        voffA[i] = (unsigned)(R * Kb + C * 2); voffB[i] = (unsigned)(Rb * Kb + C * 2); }
    unsigned gc0[2], gc1[2], gn0[2], gn1[2]; int gR[2], gC[2];
    if constexpr (GATHER) {
#pragma unroll
        for (int i = 0; i < 2; ++i) { stage_rc(tid * 16 + i * 8192, gR[i], gC[i]); gc0[i] = gc1[i] = gn0[i] = gn1[i] = 0u; }
    }
#define PG8_GOFF(pm_, o0, o1) do { _Pragma("unroll") for (int _i = 0; _i < 2; ++_i) { \
        o0[_i] = (unsigned)rowmap[(pm_) * BM + gR[_i]] * (unsigned)Kb + (unsigned)(gC[_i] * 2); o1[_i] = (unsigned)rowmap[(pm_) * BM + HALF + gR[_i]] * (unsigned)Kb + (unsigned)(gC[_i] * 2); } } while (0)
    const size_t kstep = (size_t)(BK * 2);
    const size_t hstep = (size_t)HALF * Kb;
    const size_t tstep = 2 * hstep;
    const unsigned ldsw = (unsigned)wid * 1024u;
    const int aoff = lds_byte(wr * 64 + fr, fq * 8), boff = lds_byte(wc * 32 + fr, fq * 8);
#define PG8_SA(b, h) (((b) * 2 + (h)) * HTB)
#define PG8_SB(b, h) ((4 + (b) * 2 + (h)) * HTB)
#define PG8_STAGE(bufoff, gbase, voff) do { _Pragma("unroll") for (int _i = 0; _i < 2; ++_i) \
        __builtin_amdgcn_global_load_lds((const unsigned*)((const char*)(gbase) + (voff)[_i]), (PG8_LAS unsigned*)(lds + (bufoff) + ldsw + _i * 8192), 16, 0, 0); } while (0)
#define PG8_STAGE_A(bufoff, gbase, half, usenext) do { if constexpr (GATHER) { _Pragma("unroll") for (int _i = 0; _i < 2; ++_i) { const unsigned _o = (usenext) ? ((half) ? gn1[_i] : gn0[_i]) : ((half) ? gc1[_i] : gc0[_i]); \
        __builtin_amdgcn_global_load_lds((const unsigned*)((const char*)(gbase) + _o), (PG8_LAS unsigned*)(lds + (bufoff) + ldsw + _i * 8192), 16, 0, 0); } } else { PG8_STAGE(bufoff, (gbase) + ((half) ? hstep : 0), voffA); } } while (0)
#define PG8_V4(p) (*(const PG8_LAS v4i_*)(p))
#define PG8_LDA(dst, b, h) do { if constexpr (FP8) { _Pragma("unroll") for (int m = 0; m < 4; ++m) dst##8[m] = __builtin_shufflevector(PG8_V4(lds + PG8_SA(b, h) + aoff + m * 2048), PG8_V4(lds + PG8_SA(b, h) + aoff + m * 2048 + 1024), 0, 1, 2, 3, 4, 5, 6, 7); } \
    else { _Pragma("unroll") for (int m = 0; m < 4; ++m) _Pragma("unroll") for (int k = 0; k < 2; ++k) dst[m][k] = *(const PG8_LAS bf16x8*)(lds + PG8_SA(b, h) + aoff + m * 2048 + k * 1024); } } while (0)
#define PG8_LDB(dst, b, h) do { if constexpr (FP8) { _Pragma("unroll") for (int n = 0; n < 2; ++n) dst##8[n] = __builtin_shufflevector(PG8_V4(lds + PG8_SB(b, h) + boff + n * 2048), PG8_V4(lds + PG8_SB(b, h) + boff + n * 2048 + 1024), 0, 1, 2, 3, 4, 5, 6, 7); } \
    else { _Pragma("unroll") for (int n = 0; n < 2; ++n) _Pragma("unroll") for (int k = 0; k < 2; ++k) dst[n][k] = *(const PG8_LAS bf16x8*)(lds + PG8_SB(b, h) + boff + n * 2048 + k * 1024); } } while (0)
#define PG8_MMA(ai, bj, At, Bt) do { __builtin_amdgcn_s_setprio(1); _Pragma("unroll") for (int m = 0; m < 4; ++m) _Pragma("unroll") for (int n = 0; n < 2; ++n) { \
        if constexpr (FP8) { asm volatile("v_mfma_scale_f32_16x16x128_f8f6f4 %0, %1, %2, %0, %3, %3 op_sel_hi:[0,0,0]" : "+v"(acc[ai][bj][m][n]) : "v"(Bt##8[n]), "v"(At##8[m]), "v"(mxs)); }   \
        else { _Pragma("unroll") for (int k = 0; k < 2; ++k) acc[ai][bj][m][n] = __builtin_amdgcn_mfma_f32_16x16x32_bf16(Bt[n][k], At[m][k], acc[ai][bj][m][n], 0, 0, 0); } } \
        __builtin_amdgcn_s_setprio(0); } while (0)
#define PG8_WAIT_V(n) asm volatile("s_waitcnt vmcnt(" #n ")" ::: "memory")
#define PG8_WAIT_L(n) asm volatile("s_waitcnt lgkmcnt(" #n ")" ::: "memory")
#define PG8_BAR __builtin_amdgcn_s_barrier()
#define PG8_SCHED __builtin_amdgcn_sched_barrier(0)
    Unit cur, nxt; int ui = 0;
    if (!S.next(0, cur)) return;
    f32x4 acc[2][2][4][2];
#pragma unroll
    for (int a = 0; a < 2; ++a)
#pragma unroll
        for (int b = 0; b < 2; ++b)
#pragma unroll
            for (int m = 0; m < 4; ++m)
#pragma unroll
                for (int n = 0; n < 2; ++n) acc[a][b][m][n] = (f32x4){0.f, 0.f, 0.f, 0.f};
    typedef int v4i_ __attribute__((ext_vector_type(4))); typedef int v8i_ __attribute__((ext_vector_type(8)));
    const int mxs = 0x7f7f7f7f;
    bf16x8 At[4][2], B0[2][2], B1[2][2]; v8i_ At8[4], B08[2], B18[2];
    const char* cA = (const char*)g.A + (GATHER ? (size_t)0 : (size_t)cur.pm * tstep); const char* cB = (const char*)g.Bt + (size_t)cur.pn * tstep;
    if constexpr (GATHER) { PG8_GOFF(cur.pm, gc0, gc1); }
    S.a_ready(cur);
    if constexpr (SP2) {
        PG8_STAGE(PG8_SB(0, 0), cB, voffB); PG8_STAGE(PG8_SB(0, 1), cB + hstep, voffB); PG8_STAGE_A(PG8_SA(0, 0), cA, 0, false); PG8_STAGE_A(PG8_SA(0, 1), cA, 1, false);
        if (wr == 1) PG8_BAR;
        PG8_WAIT_V(2); PG8_BAR;
        PG8_STAGE(PG8_SB(1, 0), cB + kstep, voffB); PG8_STAGE_A(PG8_SA(1, 0), cA + kstep, 0, false); PG8_STAGE(PG8_SB(1, 1), cB + hstep + kstep, voffB);
        PG8_WAIT_V(6); PG8_BAR;
    } else {
        PG8_STAGE(PG8_SB(0, 0), cB, voffB); PG8_STAGE(PG8_SA(0, 0), cA, voffA); PG8_STAGE(PG8_SB(0, 1), cB + hstep, voffB); PG8_STAGE(PG8_SA(0, 1), cA + hstep, voffA);
        if (wr == 1) PG8_BAR;
        PG8_WAIT_V(4); PG8_BAR;
        PG8_STAGE(PG8_SB(1, 0), cB + kstep, voffB); PG8_STAGE(PG8_SA(1, 0), cA + kstep, voffA); PG8_STAGE(PG8_SB(1, 1), cB + hstep + kstep, voffB);
        PG8_WAIT_V(6); PG8_BAR;
    }
    for (;;) {
        const bool has_next = S.next(ui + 1, nxt);
        const char* nA = (has_next && !GATHER) ? (const char*)g.A + (size_t)nxt.pm * tstep : (GATHER ? (const char*)g.A : cA);
        if constexpr (GATHER) { if (has_next) { PG8_GOFF(nxt.pm, gn0, gn1); } else { gn0[0] = gc0[0]; gn0[1] = gc0[1]; gn1[0] = gc1[0]; gn1[1] = gc1[1]; } } const char* nB = has_next ? (const char*)g.Bt + (size_t)nxt.pn * tstep : cB;
        for (int t = 0; t < nt; t += 2) {
            const bool last = (t == nt - 2);
            const char* a1 = cA + (size_t)(t + 1) * kstep;
            const char* a2 = last ? nA : cA + (size_t)(t + 2) * kstep; const char* b2 = last ? nB : cB + (size_t)(t + 2) * kstep;
            const char* a3 = a2 + kstep; const char* b3 = b2 + kstep;
            if (last && has_next) S.a_ready(nxt);
            if constexpr (SP2) {
            PG8_LDB(B0, 0, 0); PG8_LDB(B1, 0, 1); PG8_SCHED; PG8_LDA(At, 0, 0); PG8_STAGE_A(PG8_SA(1, 1), a1, 1, false);
            PG8_WAIT_V(8); PG8_WAIT_L(0); PG8_BAR; PG8_MMA(0, 0, At, B0); PG8_MMA(0, 1, At, B1); PG8_BAR; PG8_SCHED;
            PG8_LDA(At, 0, 1); PG8_STAGE(PG8_SB(0, 0), b2, voffB); PG8_STAGE(PG8_SB(0, 1), b2 + hstep, voffB); PG8_STAGE_A(PG8_SA(0, 0), a2, 0, last);
            PG8_WAIT_V(8); PG8_WAIT_L(0); PG8_BAR; PG8_MMA(1, 0, At, B0); PG8_MMA(1, 1, At, B1); PG8_BAR; PG8_SCHED;
            PG8_LDB(B0, 1, 0); PG8_LDB(B1, 1, 1); PG8_SCHED; PG8_LDA(At, 1, 0); PG8_STAGE_A(PG8_SA(0, 1), a2, 1, last);
            PG8_WAIT_V(8); PG8_WAIT_L(0); PG8_BAR; PG8_MMA(0, 0, At, B0); PG8_MMA(0, 1, At, B1); PG8_BAR; PG8_SCHED;
            PG8_LDA(At, 1, 1); PG8_STAGE(PG8_SB(1, 0), b3, voffB); PG8_STAGE(PG8_SB(1, 1), b3 + hstep, voffB); PG8_STAGE_A(PG8_SA(1, 0), a3, 0, last);
            PG8_WAIT_V(8); PG8_WAIT_L(0); PG8_BAR; PG8_MMA(1, 0, At, B0); PG8_MMA(1, 1, At, B1); PG8_BAR; PG8_SCHED;
            } else {
            PG8_LDB(B0, 0, 0); PG8_SCHED; PG8_LDA(At, 0, 0); PG8_STAGE(PG8_SA(1, 1), a1 + hstep, voffA);
            PG8_WAIT_L(8); PG8_BAR; PG8_WAIT_L(0); PG8_MMA(0, 0, At, B0); PG8_BAR; PG8_SCHED;
            PG8_LDB(B1, 0, 1); PG8_STAGE(PG8_SB(0, 0), b2, voffB);
            PG8_BAR; PG8_WAIT_L(0); PG8_MMA(0, 1, At, B1); PG8_BAR;
            PG8_LDA(At, 0, 1); PG8_STAGE(PG8_SA(0, 0), a2, voffA);
            PG8_BAR; PG8_WAIT_L(0); PG8_MMA(1, 0, At, B0); PG8_BAR; PG8_SCHED;
            PG8_STAGE(PG8_SB(0, 1), b2 + hstep, voffB);
            PG8_WAIT_V(6); PG8_BAR; PG8_MMA(1, 1, At, B1); PG8_BAR;
            PG8_LDB(B0, 1, 0); PG8_SCHED; PG8_LDA(At, 1, 0); PG8_STAGE(PG8_SA(0, 1), a2 + hstep, voffA);
            PG8_WAIT_L(8); PG8_BAR; PG8_WAIT_L(0); PG8_MMA(0, 0, At, B0); PG8_BAR; PG8_SCHED;
            PG8_LDB(B1, 1, 1); PG8_STAGE(PG8_SB(1, 0), b3, voffB);
            PG8_BAR; PG8_WAIT_L(0); PG8_MMA(0, 1, At, B1); PG8_BAR;
            PG8_LDA(At, 1, 1); PG8_STAGE(PG8_SA(1, 0), a3, voffA);
            PG8_BAR; PG8_WAIT_L(0); PG8_MMA(1, 0, At, B0); PG8_BAR; PG8_SCHED;
            PG8_STAGE(PG8_SB(1, 1), b3 + hstep, voffB);
            PG8_WAIT_V(6); PG8_BAR; PG8_MMA(1, 1, At, B1); PG8_BAR;
            }
        }
        if constexpr (FP8) { asm volatile("s_nop 15\n\ts_nop 15\n\ts_nop 15" ::: "memory"); }
        if constexpr (ALIGN_EPI) { if (wr == 0) PG8_BAR; }
        if constexpr (!Epi::AFTER_DRAIN) { E(acc, cur, wr, wc, fr, fq); S.done(cur); }
        if (!has_next) break;
#pragma unroll
        for (int a = 0; a < 2; ++a)
#pragma unroll
            for (int b = 0; b < 2; ++b)
#pragma unroll
                for (int m = 0; m < 4; ++m)
#pragma unroll
                    for (int n = 0; n < 2; ++n) acc[a][b][m][n] = (f32x4){0.f, 0.f, 0.f, 0.f};
        cur = nxt; cA = nA; cB = nB; ++ui;
        if constexpr (GATHER) { gc0[0] = gn0[0]; gc0[1] = gn0[1]; gc1[0] = gn1[0]; gc1[1] = gn1[1]; }
        if constexpr (ALIGN_EPI) { if (wr == 1) PG8_BAR; }
    }
    PG8_WAIT_V(0);
    if constexpr (!ALIGN_EPI) { if (wr == 0) PG8_BAR; }
    PG8_BAR;
    if constexpr (Epi::AFTER_DRAIN) { E.fused(acc, cur, wr, wc, fr, fq, lds, wid, lane); S.done(cur); }
#undef PG8_SA
#undef PG8_SB
#undef PG8_STAGE
#undef PG8_STAGE_A
#undef PG8_GOFF
#undef PG8_LDA
#undef PG8_V4
#undef PG8_LDB
#undef PG8_MMA
#undef PG8_WAIT_V
#undef PG8_WAIT_L
#undef PG8_BAR
#undef PG8_SCHED
}
}
using pg8::bf16_t; using pg8::bf16x8; using pg8::f32x4; using pg8::u32x4; using pg8::cvt_pk_bf16; using pg8::pk_fp8x4;
typedef short s16x4 __attribute__((ext_vector_type(4)));
using pg8::u32x2;
#ifndef MOE_FP8_ON
#define MOE_FP8_ON 1
#endif
#ifndef IN_FP8_ON
#define IN_FP8_ON 0
#endif
#ifndef OUT_FP8_ON
#define OUT_FP8_ON 1
#endif
#ifndef IN1_FP8_ON
#define IN1_FP8_ON 1
#endif
constexpr bool IN_FP8 = (IN_FP8_ON != 0), OUT_FP8 = (OUT_FP8_ON != 0), IN1_FP8 = (IN1_FP8_ON != 0) || IN_FP8;
constexpr bool MOE_FP8 = (MOE_FP8_ON != 0);
#ifndef CVT_OVERLAP_WG
#define CVT_OVERLAP_WG 0
#endif
constexpr int CVT_WG = CVT_OVERLAP_WG;
#define PROBE_CAT_(a, b) a##b
#ifndef PROBE_HS1
#define PROBE_HS1 1
#endif
#ifndef PROBE_SWA
#define PROBE_SWA 1
#endif
#ifndef PROBE_HSC
#define PROBE_HSC 1
#endif
#ifndef PROBE_HS3
#define PROBE_HS3 1
#endif
#ifndef PROBE_CMP
#define PROBE_CMP 1
#endif
#ifndef PROBE_RS1
#define PROBE_RS1 1
#endif
#ifndef PROBE_RSC
#define PROBE_RSC 1
#endif
#ifndef PROBE_NSA
#define PROBE_NSA 1
#endif
#ifndef PROBE_RS3
#define PROBE_RS3 1
#endif
#ifndef PROBE_G10
#define PROBE_G10 1
#endif
#ifndef PROBE_G11
#define PROBE_G11 1
#endif
#ifndef PROBE_P0
#define PROBE_P0 1
#endif
#ifndef PROBE_C12
#define PROBE_C12 1
#endif
#ifndef IN0_BF_COLS
#define IN0_BF_COLS 3072
#endif
#ifndef PROBE_G17
#define PROBE_G17 1
#endif
#ifndef PROBE_NSA_SKIP
#define PROBE_NSA_SKIP 0
#endif
#ifndef PROBE_SEL
#define PROBE_SEL 1
#endif
#ifndef PROBE_B2
#define PROBE_B2 1
#endif
#ifndef PROBE_B3
#define PROBE_B3 1
#endif
#ifndef PROBE_NR
#define PROBE_NR 1
#endif
#ifndef PROBE_CMB
#define PROBE_CMB 1
#endif
#ifndef PROBE_G5
#define PROBE_G5 1
#endif
#ifndef PROBE_G13
#define PROBE_G13 1
#endif
#define PROBE_REP(name) PROBE_CAT_(PROBE_, name)
constexpr int NTHR = 512, NWAVE = 8;
constexpr int DM = 2048, NBATCH = 8, SEQ = 4096, MTOK = NBATCH * SEQ;
constexpr int IN0_BF = IN0_BF_COLS;
constexpr int NAB = 5632, NCD = 5888, LDP = 5888;
constexpr int C_HQ = 0, C_HF = 1024, C_HI = 2048, C_HG = 3072, C_SQ = 4096, C_SK = 5120, C_SV = 5376;
constexpr int C_NQ = 0, C_NKC = 1024, C_NVC = 1280, C_NKS = 1536, C_NVS = 1792, C_NKW = 2048, C_NVW = 2304, C_RQ = 2560, C_RK = 3072, C_RV = 3584, C_RG = 4608, C_GT = 5632;
constexpr int NEXP = 32, DFF = 1024, MOE_MAXROWS = 73728, MOE_MAXTILES = 288;
constexpr float RMS_EPS = 1e-6f, LOG2E = 1.4426950408889634f;
constexpr int LDS_BYTES = 163840;
constexpr size_t al256(size_t x) { return (x + 255) & ~(size_t)255; }
constexpr size_t WS_CTL = 0, CTL_BYTES = 65536;
constexpr int CW_CNT = 4096, CW_CUR = 4096 + 64, CW_RT = 4096 + 128;
constexpr size_t WS_WAB_IN = WS_CTL + CTL_BYTES;
constexpr size_t WS_WAB_OUT = WS_WAB_IN + (size_t)NAB * DM * 2;
constexpr size_t WS_WCD_IN = WS_WAB_OUT + (size_t)DM * DM * 2;
constexpr size_t WS_WCD_OUT = WS_WCD_IN + (size_t)NCD * DM * 2;
constexpr size_t WS_WRT = WS_WCD_OUT + (size_t)DM * DM * 2;
constexpr size_t WS_W1 = WS_WRT + (size_t)2 * 256 * DM * 2;
constexpr size_t WS_W2 = WS_W1 + (size_t)NEXP * 2048 * DM * 2;
constexpr size_t WS_NW1 = WS_W2 + (size_t)NEXP * DM * DFF * 2;
constexpr size_t WS_NW2 = WS_NW1 + (size_t)2 * 128 * 4096 * 2;
constexpr size_t WS_NBIAS = WS_NW2 + (size_t)2 * 128 * 128 * 2;
constexpr size_t WS_LB = WS_NBIAS + 16384;
constexpr size_t WS_HN = al256(WS_LB + 4096);
constexpr size_t WS_PROJ = WS_HN + (size_t)MTOK * DM * 2;
constexpr size_t WS_MIX = WS_PROJ + (size_t)MTOK * LDP * 2;
constexpr size_t WS_LOG = WS_MIX + (size_t)MTOK * DM * 2;
constexpr size_t WS_RTE = WS_LOG + (size_t)MTOK * 256 * 4;
constexpr size_t WS_TEXP = WS_RTE + (size_t)MTOK * 2 * 4 * 3;
constexpr size_t WS_ROWTOK = al256(WS_TEXP + 4096);
constexpr size_t WS_KCMP = al256(WS_ROWTOK + (size_t)MOE_MAXROWS * 4);
constexpr size_t WS_R = al256(WS_KCMP + (size_t)2 * 8 * 2 * 256 * 128 * 2);
constexpr size_t WS_XS = WS_R, WS_HID = WS_XS + (size_t)MOE_MAXROWS * DM * 2;
constexpr size_t WS_DS = WS_R, WS_SPREV = WS_DS + (size_t)4096 * 16384 * 4, WS_DEC = WS_SPREV + (size_t)4096 * 16384 * 2;
constexpr size_t WS_END0 = WS_HID + (size_t)MOE_MAXROWS * DFF * 2;
constexpr size_t WS_KV = WS_END0, WS_RPREV = WS_KV + (size_t)1024 * 32768 * 4;
constexpr size_t WS_HN8 = WS_RPREV + (size_t)1024 * 32768 * 2;
constexpr size_t WS_MIX8 = WS_HN8 + (size_t)MTOK * DM;
constexpr size_t WS_END = WS_MIX8 + (size_t)MTOK * DM;
static_assert(WS_DEC + (size_t)4096 * 128 * 4 <= WS_END0, "aliased region");
static_assert(WS_END <= ((size_t)1 << 31), "workspace must fit 2 GiB");

#define LAS __attribute__((address_space(3)))
typedef LAS unsigned char* ldsp;
__device__ __forceinline__ float bf2f(bf16_t b) { return __uint_as_float(((unsigned)b) << 16); }
__device__ __forceinline__ float bflo(unsigned w) { return __uint_as_float(w << 16); }
__device__ __forceinline__ float bfhi(unsigned w) { return __uint_as_float(w & 0xffff0000u); }
__device__ __forceinline__ bf16_t f2bf(float f) { return (bf16_t)(cvt_pk_bf16(f, 0.f) & 0xffffu); }
constexpr float ACT8_SCALE = 8.0f, ACT8_DESCALE = 0.03125f / 8.0f;
__device__ __forceinline__ unsigned char f2fp8(float f) { return (unsigned char)(__builtin_amdgcn_cvt_pk_fp8_f32(f, 0.f, 0, false) & 0xff); }
__device__ __forceinline__ unsigned pk2(float lo, float hi) { return cvt_pk_bf16(lo, hi); }
__device__ __forceinline__ f32x4 mfma16(bf16x8 a, bf16x8 b, f32x4 c) { return __builtin_amdgcn_mfma_f32_16x16x32_bf16(a, b, c, 0, 0, 0); }
__device__ __forceinline__ float sigmoidf_(float x) { return __builtin_amdgcn_rcpf(1.0f + __expf(-x)); }
__device__ __forceinline__ float wave_sum(float v) { for (int o = 32; o >= 1; o >>= 1) v += __shfl_xor(v, o); return v; }
template <int N> __device__ __forceinline__ float dpp_ror(float v) { return __builtin_bit_cast(float, __builtin_amdgcn_update_dpp(0, __builtin_bit_cast(int, v), 0x120 + N, 0xF, 0xF, false)); }
__device__ __forceinline__ float grp16_sum(float v) { v += dpp_ror<8>(v); v += dpp_ror<4>(v); v += dpp_ror<2>(v); v += dpp_ror<1>(v); return v; }
__device__ __forceinline__ float grp16_max(float v) { v = fmaxf(v, dpp_ror<8>(v)); v = fmaxf(v, dpp_ror<4>(v)); v = fmaxf(v, dpp_ror<2>(v)); v = fmaxf(v, dpp_ror<1>(v)); return v; }
__device__ __forceinline__ unsigned lds_addr(ldsp p) { return (unsigned)(size_t)p; }
__device__ __forceinline__ unsigned tr_lane_off(int lane, int rs) { return (unsigned)((8 * (lane >> 4) + ((lane & 15) >> 2)) * rs + (lane & 3) * 8); }
__device__ __forceinline__ bf16x8 tr_frag(unsigned a, int rs) {
    s16x4 lo, hi; const unsigned a1 = a + 4 * rs;
    asm volatile("ds_read_b64_tr_b16 %0, %2\n\tds_read_b64_tr_b16 %1, %3\n\ts_waitcnt lgkmcnt(0)" : "=&v"(lo), "=&v"(hi) : "v"(a), "v"(a1) : "memory");
    bf16x8 r; r[0] = lo[0]; r[1] = lo[1]; r[2] = lo[2]; r[3] = lo[3]; r[4] = hi[0]; r[5] = hi[1]; r[6] = hi[2]; r[7] = hi[3]; return r;
}
__device__ __forceinline__ void tr_frag2(unsigned a, unsigned b, int rs, bf16x8& ra, bf16x8& rb) {
    s16x4 l0, h0, l1, h1; const unsigned a1 = a + 4 * rs, b1 = b + 4 * rs;
    asm volatile("ds_read_b64_tr_b16 %0, %4\n\tds_read_b64_tr_b16 %1, %5\n\tds_read_b64_tr_b16 %2, %6\n\tds_read_b64_tr_b16 %3, %7\n\ts_waitcnt lgkmcnt(0)"
                 : "=&v"(l0), "=&v"(h0), "=&v"(l1), "=&v"(h1) : "v"(a), "v"(a1), "v"(b), "v"(b1) : "memory");
    ra[0] = l0[0]; ra[1] = l0[1]; ra[2] = l0[2]; ra[3] = l0[3]; ra[4] = h0[0]; ra[5] = h0[1]; ra[6] = h0[2]; ra[7] = h0[3];
    rb[0] = l1[0]; rb[1] = l1[1]; rb[2] = l1[2]; rb[3] = l1[3]; rb[4] = h1[0]; rb[5] = h1[1]; rb[6] = h1[2]; rb[7] = h1[3];
}
__device__ __forceinline__ int opq(int x) { asm volatile("" : "+v"(x)); return x; }
#define LDS_FENCE() asm volatile("s_waitcnt lgkmcnt(0)" ::: "memory")

struct Frame {
    const float* in[25]; float* out; unsigned char* ws; ldsp lds;
    int tid, lane, wave, G, bid;
};
#define PHASE_FRAME(F0) Frame F = (F0); { int t_ = (F0).tid; asm volatile("" : "+v"(t_)); F.tid = t_; F.lane = t_ & 63; F.wave = __builtin_amdgcn_readfirstlane(t_ >> 6); }
template <int MODE> __device__ __forceinline__ float4 cvt_load(const float* s0, const float* s1, int ld, int k, int n, int nvalid) {
    const float* p = nullptr;
    if (MODE == 0) { if (n < nvalid) p = s0 + (size_t)k * ld + n; }
    else if (MODE == 1) { if (n < 2560) p = s0 + (size_t)k * ld + n; else if (n < 5632) p = s0 + (size_t)k * ld + n + 24; else if (n < 5656) p = s0 + (size_t)k * ld + (n - 5632 + 2560); }
    else if (MODE == 2) { const int idx = 128 * (n >> 8) + (n & 127); p = (((n >> 7) & 1) ? s1 : s0) + (size_t)k * ld + idx; }
    else { if (n < 4) p = s0 + (size_t)k * 4 + n; else if (n < 36) p = s1 + (size_t)k * 32 + (n - 4); }
    if (p) return *(const float4*)p;
    return make_float4(0.f, 0.f, 0.f, 0.f);
}
template <int MODE, bool OUT8 = false> __device__ __forceinline__ void cvt_job(const Frame& F, const float* s0, const float* s1, bf16_t* dst, int ld, int K, int nnt, int nvalid, int nbatch, size_t sb, size_t db, int& rr) {
    constexpr int RS = 272;
    const int nkt = (K + 127) / 128, nnt2 = 2 * nnt, per = nkt * nnt2, ntiles = per * nbatch;
    const int first = (F.bid - (rr % F.G) + F.G) % F.G;
    const int lr = F.lane >> 5, lc = 4 * (F.lane & 31);
    float4 v[8];
    auto load_tile = [&](int tile) { const int e = tile / per, t2 = tile - e * per, nt = t2 % nnt2, kt = t2 / nnt2;
        const float* a0 = s0 + (size_t)e * sb; const float* a1 = s1 ? s1 + (size_t)e * sb : nullptr;
#pragma unroll
        for (int r = 0; r < 8; ++r) { const int k = kt * 128 + F.wave * 16 + 2 * r + lr; v[r] = (k < K) ? cvt_load<MODE>(a0, a1, ld, k, nt * 128 + lc, nvalid) : make_float4(0.f, 0.f, 0.f, 0.f); } };
    int tile = first;
    if (tile < ntiles) load_tile(tile);
    while (tile < ntiles) {
        const int e = tile / per, t2 = tile - e * per, nt = t2 % nnt2, kt = t2 / nnt2;
#pragma unroll
        for (int r = 0; r < 8; ++r) { u32x2 w; w.x = pk2(v[r].x, v[r].y); w.y = pk2(v[r].z, v[r].w); *(LAS u32x2*)(F.lds + (F.wave * 16 + 2 * r + lr) * RS + 2 * lc) = w; }
        __syncthreads();
        const int next = tile + F.G;
        if (next < ntiles) load_tile(next);
        bf16_t* d = dst + (size_t)e * db;
        const unsigned tb = lds_addr(F.lds) + tr_lane_off(F.lane, RS) + 32 * F.wave;
        const int n = nt * 128 + 16 * F.wave + (F.lane & 15);
#pragma unroll
        for (int kb = 0; kb < 4; kb += 2) { bf16x8 f0, f1; tr_frag2(tb + 32 * kb * RS, tb + 32 * (kb + 1) * RS, RS, f0, f1);
            const int k0 = kt * 128 + 32 * kb + 8 * (F.lane >> 4);
            if constexpr (OUT8) {
                unsigned char* d8 = (unsigned char*)dst + (size_t)e * db;
                u32x2 w0, w1;
                w0.x = pk_fp8x4(32.f * bf2f((bf16_t)f0[0]), 32.f * bf2f((bf16_t)f0[1]), 32.f * bf2f((bf16_t)f0[2]), 32.f * bf2f((bf16_t)f0[3])); w0.y = pk_fp8x4(32.f * bf2f((bf16_t)f0[4]), 32.f * bf2f((bf16_t)f0[5]), 32.f * bf2f((bf16_t)f0[6]), 32.f * bf2f((bf16_t)f0[7]));
                w1.x = pk_fp8x4(32.f * bf2f((bf16_t)f1[0]), 32.f * bf2f((bf16_t)f1[1]), 32.f * bf2f((bf16_t)f1[2]), 32.f * bf2f((bf16_t)f1[3])); w1.y = pk_fp8x4(32.f * bf2f((bf16_t)f1[4]), 32.f * bf2f((bf16_t)f1[5]), 32.f * bf2f((bf16_t)f1[6]), 32.f * bf2f((bf16_t)f1[7]));
                if (n < nvalid && k0 < K) *(u32x2*)(d8 + (size_t)n * K + k0) = w0;
                if (n < nvalid && k0 + 32 < K) *(u32x2*)(d8 + (size_t)n * K + k0 + 32) = w1;
            } else {
            if (n < nvalid && k0 < K) *(bf16x8*)(d + (size_t)n * K + k0) = f0;
            if (n < nvalid && k0 + 32 < K) *(bf16x8*)(d + (size_t)n * K + k0 + 32) = f1; } }
        __syncthreads();
        tile = next;
    }
    rr += ntiles;
}
__device__ __forceinline__ void convert_moe_layer(const Frame& F, int layer, int& rr) {
    const size_t wsz = (size_t)NEXP * DM * DFF;
    cvt_job<2, MOE_FP8>(F, F.in[22] + layer * wsz, F.in[23] + layer * wsz, (bf16_t*)(F.ws + WS_W1), DFF, DM, 8, 2048, NEXP, (size_t)DM * DFF, (size_t)2048 * DM, rr);
    cvt_job<0, MOE_FP8>(F, F.in[24] + layer * wsz, nullptr, (bf16_t*)(F.ws + WS_W2), DM, DFF, 8, 2048, NEXP, (size_t)DFF * DM, (size_t)DM * DFF, rr);
}
template <bool OUT8 = false> __device__ __forceinline__ void rmsnorm_rows(const Frame& F0, const float* src, const float* w, bf16_t* dst) { PHASE_FRAME(F0);
    for (int row = F.bid * NWAVE + F.wave; row < MTOK; row += F.G * NWAVE) {
        const float4* p = (const float4*)(src + (size_t)row * DM); float4 v[8]; float ss = 0.f;
#pragma unroll
        for (int i = 0; i < 8; ++i) { v[i] = p[F.lane + 64 * i]; ss += v[i].x * v[i].x + v[i].y * v[i].y + v[i].z * v[i].z + v[i].w * v[i].w; }
        ss = wave_sum(ss); const float rstd = rsqrtf(ss * (1.0f / DM) + RMS_EPS);
#pragma unroll
        for (int i = 0; i < 8; ++i) { const float4 g = ((const float4*)w)[F.lane + 64 * i];
            if constexpr (OUT8) *(unsigned*)((unsigned char*)(F.ws + WS_HN8) + (size_t)row * DM + 4 * (F.lane + 64 * i)) = pk_fp8x4(v[i].x * rstd * g.x, v[i].y * rstd * g.y, v[i].z * rstd * g.z, v[i].w * rstd * g.w);
            { u32x2 o; o.x = pk2(v[i].x * rstd * g.x, v[i].y * rstd * g.y); o.y = pk2(v[i].z * rstd * g.z, v[i].w * rstd * g.w); *(u32x2*)(dst + (size_t)row * DM + 4 * (F.lane + 64 * i)) = o; } }
    }
}
__device__ __forceinline__ void p0_prologue(const Frame& F0) { PHASE_FRAME(F0);
    int rr = 0;
    cvt_job<0, false>(F, F.in[4], nullptr, (bf16_t*)(F.ws + WS_WAB_IN), NAB, DM, IN0_BF / 256, IN0_BF, 1, 0, 0, rr);
    cvt_job<0, true>(F, F.in[4] + IN0_BF, nullptr, (bf16_t*)(F.ws + WS_WAB_IN + (size_t)IN0_BF * DM * 2), NAB, DM, (NAB - IN0_BF) / 256, NAB - IN0_BF, 1, 0, 0, rr);
    cvt_job<0, OUT_FP8>(F, F.in[5], nullptr, (bf16_t*)(F.ws + WS_WAB_OUT), DM, DM, 8, DM, 1, 0, 0, rr);
    cvt_job<1, IN1_FP8>(F, F.in[9], nullptr, (bf16_t*)(F.ws + WS_WCD_IN), 5656, DM, 23, NCD, 1, 0, 0, rr);
    cvt_job<0, OUT_FP8>(F, F.in[10], nullptr, (bf16_t*)(F.ws + WS_WCD_OUT), DM, DM, 8, DM, 1, 0, 0, rr);
    cvt_job<3>(F, F.in[18], F.in[20], (bf16_t*)(F.ws + WS_WRT), 0, DM, 1, 256, 1, 0, 0, rr);
    cvt_job<3>(F, F.in[18] + DM * 4, F.in[20] + DM * 32, (bf16_t*)(F.ws + WS_WRT) + 256 * DM, 0, DM, 1, 256, 1, 0, 0, rr);
    cvt_job<0>(F, F.in[12], nullptr, (bf16_t*)(F.ws + WS_NW1), 128, 4096, 1, 128, 1, 0, 0, rr);
    cvt_job<0>(F, F.in[15], nullptr, (bf16_t*)(F.ws + WS_NW1) + 128 * 4096, 128, 4096, 1, 128, 1, 0, 0, rr);
    cvt_job<0>(F, F.in[13], nullptr, (bf16_t*)(F.ws + WS_NW2), 128, 128, 1, 128, 1, 0, 0, rr);
    cvt_job<0>(F, F.in[16], nullptr, (bf16_t*)(F.ws + WS_NW2) + 128 * 128, 128, 128, 1, 128, 1, 0, 0, rr);
    if (CVT_WG == 0) convert_moe_layer(F, 0, rr);
    if (F.bid == 0) {
        const float* z = F.in[6];
        for (int c = F.tid; c < 1024; c += NTHR) { const float a = z[c], b = z[1024 + c], d = z[2048 + c], m = fmaxf(a, fmaxf(b, d)); const float ea = __expf(a - m), eb = __expf(b - m), ed = __expf(d - m);
            ((float*)(F.ws + WS_LB))[c] = ea / (ea + eb + ed); }
    }
    if (F.bid < 16) {
        const int h = F.tid & 127, part = F.tid >> 7;
        for (int kv = 0; kv < 2; ++kv) {
            const float* pe = F.in[kv ? 14 : 11]; const float* w1 = F.in[kv ? 15 : 12]; float s = 0.f;
#pragma unroll 8
            for (int k = F.bid * 256 + part * 64; k < F.bid * 256 + part * 64 + 64; ++k) s += pe[k] * w1[(size_t)k * 128 + h];
            __syncthreads();
            ((LAS float*)F.lds)[part * 128 + h] = s;
            __syncthreads();
            if (F.tid < 128) ((float*)(F.ws + WS_NBIAS))[(kv * 16 + F.bid) * 128 + F.tid] = (((LAS float*)F.lds)[F.tid] + ((LAS float*)F.lds)[128 + F.tid]) + (((LAS float*)F.lds)[256 + F.tid] + ((LAS float*)F.lds)[384 + F.tid]);
            __syncthreads();
        }
    }
    rmsnorm_rows<true>(F, F.in[0], F.in[1], (bf16_t*)(F.ws + WS_HN));
}
__device__ __forceinline__ void route_phase(const Frame& F0, int layer) { PHASE_FRAME(F0);
    const float* LG = (const float*)(F.ws + WS_LOG); const float* bg = F.in[19] + layer * 4; const float* be = F.in[21] + layer * 32;
    int* rexp = (int*)(F.ws + WS_RTE); float* rgate = (float*)(F.ws + WS_RTE + (size_t)MTOK * 8);
    unsigned* cnt = (unsigned*)(F.ws + WS_CTL) + CW_CNT + layer * 32;
    LAS unsigned* hist = (LAS unsigned*)F.lds;
    for (int i = F.bid * NTHR + F.tid; i < MOE_MAXROWS; i += F.G * NTHR) ((int*)(F.ws + WS_ROWTOK))[i] = 0;
    for (int ch = F.bid; ch < MTOK / 128; ch += F.G) {
        if (F.tid < 32) hist[F.tid] = 0u;
        __syncthreads();
        if (F.tid < 128) {
            const int tok = ch * 128 + F.tid; const float* l = LG + (size_t)tok * 256;
            float gl[4]; int gi = 0; float gm = -INFINITY;
#pragma unroll
            for (int i = 0; i < 4; ++i) { gl[i] = l[i] + bg[i]; if (gl[i] > gm) { gm = gl[i]; gi = i; } }
            float gs = 0.f;
#pragma unroll
            for (int i = 0; i < 4; ++i) gs += __expf(gl[i] - gm);
            const float pg = 1.0f / gs;
            float el[8]; float em = -INFINITY;
#pragma unroll
            for (int i = 0; i < 8; ++i) { el[i] = l[4 + gi * 8 + i] + be[gi * 8 + i]; em = fmaxf(em, el[i]); }
            int i0 = 0; float v0 = -INFINITY;
#pragma unroll
            for (int i = 0; i < 8; ++i) if (el[i] > v0) { v0 = el[i]; i0 = i; }
            int i1 = 0; float v1 = -INFINITY;
#pragma unroll
            for (int i = 0; i < 8; ++i) if (i != i0 && el[i] > v1) { v1 = el[i]; i1 = i; }
            const float p0 = __expf(v0 - em), p1 = __expf(v1 - em), inv = pg / (p0 + p1);
            const int e0 = gi * 8 + i0, e1 = gi * 8 + i1;
            rexp[tok * 2] = e0; rexp[tok * 2 + 1] = e1; rgate[tok * 2] = p0 * inv; rgate[tok * 2 + 1] = p1 * inv;
            __hip_atomic_fetch_add(&hist[e0], 1u, __ATOMIC_RELAXED, __HIP_MEMORY_SCOPE_WORKGROUP); __hip_atomic_fetch_add(&hist[e1], 1u, __ATOMIC_RELAXED, __HIP_MEMORY_SCOPE_WORKGROUP);
        }
        __syncthreads();
        if (F.tid < 32 && hist[F.tid]) __hip_atomic_fetch_add(cnt + F.tid, hist[F.tid], __ATOMIC_RELAXED, __HIP_MEMORY_SCOPE_AGENT);
        __syncthreads();
    }
}
constexpr int NR_TILE = 0, NR_PITCH = 4112, NR_PART = 16 * NR_PITCH, NR_LOGS = NR_PART + 8 * 16 * 48 * 4, NR_HIST = NR_LOGS + 16 * 48 * 4;
__device__ __forceinline__ void norm_route_phase(const Frame& F0, int layer, const float* w) { PHASE_FRAME(F0);
    const bf16_t* H = layer ? (const bf16_t*)(F.ws + WS_PROJ) : (const bf16_t*)F.out; bf16_t* HN = (bf16_t*)(F.ws + WS_HN); const float* bg = F.in[19] + layer * 4; const float* be = F.in[21] + layer * 32;
    int* rexp = (int*)(F.ws + WS_RTE); float* rgate = (float*)(F.ws + WS_RTE + (size_t)MTOK * 8);
    unsigned* cnt = (unsigned*)(F.ws + WS_CTL) + CW_CNT + layer * 32;
    LAS float* PART = (LAS float*)(F.lds + NR_PART); LAS float* LOGS = (LAS float*)(F.lds + NR_LOGS); LAS unsigned* hist = (LAS unsigned*)(F.lds + NR_HIST);
    const int c = F.lane & 15, g4 = F.lane >> 4;
    for (int i = F.bid * NTHR + F.tid; i < MOE_MAXROWS; i += F.G * NTHR) ((int*)(F.ws + WS_ROWTOK))[i] = 0;
    if (F.tid < 32) hist[F.tid] = 0u;
    bf16x8 bfr[3][8]; { const bf16_t* wr = (const bf16_t*)(F.ws + WS_WRT) + (size_t)layer * 256 * DM;
#pragma unroll
        for (int nb = 0; nb < 3; ++nb)
#pragma unroll
            for (int ks = 0; ks < 8; ++ks) bfr[nb][ks] = *(const bf16x8*)(wr + (size_t)(16 * nb + c) * DM + 256 * F.wave + 32 * ks + 8 * g4); }
    __syncthreads();
    for (int rep_ = 0; rep_ < PROBE_NR; ++rep_) { if (rep_) { __syncthreads(); if (F.tid < 32) hist[F.tid] = 0u; __syncthreads(); }
    for (int bt = F.bid; bt < MTOK / 16; bt += F.G) {
#pragma unroll 1
        for (int rr = 0; rr < 2; ++rr) { const int r = 2 * F.wave + rr; const size_t row = (size_t)bt * 16 + r;
            const u32x2* p = (const u32x2*)(H + row * DM); float4 v[8]; float ss = 0.f;
#pragma unroll
            for (int i = 0; i < 8; ++i) { const u32x2 hv = p[F.lane + 64 * i]; v[i].x = bflo(hv.x); v[i].y = bfhi(hv.x); v[i].z = bflo(hv.y); v[i].w = bfhi(hv.y); ss += v[i].x * v[i].x + v[i].y * v[i].y + v[i].z * v[i].z + v[i].w * v[i].w; }
            ss = wave_sum(ss); const float rstd = rsqrtf(ss * (1.0f / DM) + RMS_EPS);
#pragma unroll
            for (int i = 0; i < 8; ++i) { const float4 g = ((const float4*)w)[F.lane + 64 * i]; u32x2 o; o.x = pk2(v[i].x * rstd * g.x, v[i].y * rstd * g.y); o.y = pk2(v[i].z * rstd * g.z, v[i].w * rstd * g.w);
                if (!MOE_FP8) *(u32x2*)(HN + row * DM + 4 * (F.lane + 64 * i)) = o;
                *(LAS u32x2*)(F.lds + NR_TILE + r * NR_PITCH + 8 * (F.lane + 64 * i)) = o;
                if (MOE_FP8) *(unsigned*)((unsigned char*)(F.ws + WS_HN8) + row * DM + 4 * (F.lane + 64 * i)) = pk_fp8x4(v[i].x * rstd * g.x, v[i].y * rstd * g.y, v[i].z * rstd * g.z, v[i].w * rstd * g.w); } }
        __syncthreads();
        f32x4 acc[3] = {(f32x4){0.f, 0.f, 0.f, 0.f}, (f32x4){0.f, 0.f, 0.f, 0.f}, (f32x4){0.f, 0.f, 0.f, 0.f}};
#pragma unroll
        for (int ks = 0; ks < 8; ++ks) { const bf16x8 a = *(LAS bf16x8*)(F.lds + NR_TILE + c * NR_PITCH + (256 * F.wave + 32 * ks + 8 * g4) * 2);
#pragma unroll
            for (int nb = 0; nb < 3; ++nb) acc[nb] = mfma16(a, bfr[nb][ks], acc[nb]); }
#pragma unroll
        for (int nb = 0; nb < 3; ++nb)
#pragma unroll
            for (int j = 0; j < 4; ++j) PART[(F.wave * 16 + 4 * g4 + j) * 48 + 16 * nb + c] = acc[nb][j];
        __syncthreads();
        for (int idx = F.tid; idx < 16 * 48; idx += NTHR) { float s = 0.f;
#pragma unroll
            for (int ww = 0; ww < 8; ++ww) s += PART[ww * 768 + idx];
            LOGS[idx] = s; }
        __syncthreads();
        if (F.tid < 16) {
            const int tok = bt * 16 + F.tid; const LAS float* l = LOGS + F.tid * 48;
            float gl[4]; int gi = 0; float gm = -INFINITY;
#pragma unroll
            for (int i = 0; i < 4; ++i) { gl[i] = l[i] + bg[i]; if (gl[i] > gm) { gm = gl[i]; gi = i; } }
            float gs = 0.f;
#pragma unroll
            for (int i = 0; i < 4; ++i) gs += __expf(gl[i] - gm);
            const float pg = 1.0f / gs;
            float el[8]; float em = -INFINITY;
#pragma unroll
            for (int i = 0; i < 8; ++i) { el[i] = l[4 + gi * 8 + i] + be[gi * 8 + i]; em = fmaxf(em, el[i]); }
            int i0 = 0; float v0 = -INFINITY;
#pragma unroll
            for (int i = 0; i < 8; ++i) if (el[i] > v0) { v0 = el[i]; i0 = i; }
            int i1 = 0; float v1 = -INFINITY;
#pragma unroll
            for (int i = 0; i < 8; ++i) if (i != i0 && el[i] > v1) { v1 = el[i]; i1 = i; }
            const float p0 = __expf(v0 - em), p1 = __expf(v1 - em), inv = pg / (p0 + p1);
            const int e0 = gi * 8 + i0, e1 = gi * 8 + i1;
            rexp[tok * 2] = e0; rexp[tok * 2 + 1] = e1; rgate[tok * 2] = p0 * inv; rgate[tok * 2 + 1] = p1 * inv;
            __hip_atomic_fetch_add(&hist[e0], 1u, __ATOMIC_RELAXED, __HIP_MEMORY_SCOPE_WORKGROUP); __hip_atomic_fetch_add(&hist[e1], 1u, __ATOMIC_RELAXED, __HIP_MEMORY_SCOPE_WORKGROUP);
        }
        __syncthreads();
    } }
    if (F.tid < 32 && hist[F.tid]) __hip_atomic_fetch_add(cnt + F.tid, hist[F.tid], __ATOMIC_RELAXED, __HIP_MEMORY_SCOPE_AGENT);
    __syncthreads();
}
__device__ __forceinline__ void gather_phase(const Frame& F0, int layer) { PHASE_FRAME(F0);
    const int* rexp = (const int*)(F.ws + WS_RTE); int* rdest = (int*)(F.ws + WS_RTE + (size_t)MTOK * 16);
    unsigned* ctl = (unsigned*)(F.ws + WS_CTL); unsigned* cnt = ctl + CW_CNT + layer * 32; unsigned* cur = ctl + CW_CUR + layer * 32;
    int* texp = (int*)(F.ws + WS_TEXP); int* rowtok = (int*)(F.ws + WS_ROWTOK);
    LAS unsigned* L = (LAS unsigned*)F.lds;
    if (F.tid < 32) L[385 + F.tid] = ((cnt[F.tid] + 255u) >> 8) << 8;
    __syncthreads();
    if (F.tid == 0) { unsigned acc = 0; for (int e = 0; e < 32; ++e) { L[64 + e] = acc; acc += L[385 + e]; } L[384] = acc; }
    __syncthreads();
    if (F.bid == 0) {
        const unsigned total = L[384];
        if (F.tid == 0) ctl[CW_RT + layer] = total >> 8;
        for (int t = F.tid; t < (int)(total >> 8); t += NTHR) { int e = 0; for (int k = 1; k < 32; ++k) if (L[64 + k] <= (unsigned)t * 256u) e = k; texp[t] = e; }
    }
    for (int ch = F.bid; ch < MTOK / 128; ch += F.G) {
        if (F.tid < 32) { L[F.tid] = 0u; L[96 + F.tid] = 0u; }
        __syncthreads();
        int e0 = 0, e1 = 0;
        if (F.tid < 128) { const int tok = ch * 128 + F.tid; e0 = rexp[tok * 2]; e1 = rexp[tok * 2 + 1]; __hip_atomic_fetch_add(&L[e0], 1u, __ATOMIC_RELAXED, __HIP_MEMORY_SCOPE_WORKGROUP); __hip_atomic_fetch_add(&L[e1], 1u, __ATOMIC_RELAXED, __HIP_MEMORY_SCOPE_WORKGROUP); }
        __syncthreads();
        if (F.tid < 32) L[32 + F.tid] = L[F.tid] ? __hip_atomic_fetch_add(cur + F.tid, L[F.tid], __ATOMIC_RELAXED, __HIP_MEMORY_SCOPE_AGENT) : 0u;
        __syncthreads();
        if (F.tid < 128) { const int tok = ch * 128 + F.tid;
            const unsigned d0 = L[64 + e0] + L[32 + e0] + __hip_atomic_fetch_add(&L[96 + e0], 1u, __ATOMIC_RELAXED, __HIP_MEMORY_SCOPE_WORKGROUP);
            const unsigned d1 = L[64 + e1] + L[32 + e1] + __hip_atomic_fetch_add(&L[96 + e1], 1u, __ATOMIC_RELAXED, __HIP_MEMORY_SCOPE_WORKGROUP);
            rdest[tok * 2] = (int)d0; rdest[tok * 2 + 1] = (int)d1; rowtok[d0] = tok; rowtok[d1] = tok; }
        __syncthreads();
        __syncthreads();
    }
}
template <bool FINAL> __device__ __forceinline__ void combine_phase(const Frame& F0, const float* w) { PHASE_FRAME(F0);
    const float* rgate = (const float*)(F.ws + WS_RTE + (size_t)MTOK * 8); const int* rdest = (const int*)(F.ws + WS_RTE + (size_t)MTOK * 16);
    static_assert(MOE_FP8, "combine reads e4m3 expert outputs");
    const unsigned char* YS = (const unsigned char*)(F.ws + WS_XS); float* OUT = F.out; bf16_t* H = FINAL ? (bf16_t*)(F.ws + WS_PROJ) : (bf16_t*)F.out;
    float ng0 = 0.f, ng1 = 0.f; int nd0 = 0, nd1 = 0;
    { const int row = F.bid * NWAVE + F.wave; if (row < MTOK) { ng0 = rgate[row * 2]; ng1 = rgate[row * 2 + 1]; nd0 = rdest[row * 2]; nd1 = rdest[row * 2 + 1]; } }
    for (int row = F.bid * NWAVE + F.wave; row < MTOK; row += F.G * NWAVE) {
        const float g0 = ng0 * 0.0625f, g1 = ng1 * 0.0625f; const int d0 = nd0, d1 = nd1;
        { const int nrow = row + F.G * NWAVE; if (nrow < MTOK) { ng0 = rgate[nrow * 2]; ng1 = rgate[nrow * 2 + 1]; nd0 = rdest[nrow * 2]; nd1 = rdest[nrow * 2 + 1]; } }
        const u32x4* p = (const u32x4*)(H + (size_t)row * DM); const u32x2* y0 = (const u32x2*)(YS + (size_t)d0 * DM); const u32x2* y1 = (const u32x2*)(YS + (size_t)d1 * DM);
        float v[4][8]; float ss = 0.f;
        u32x4 hv[4]; u32x2 ya[4], yb[4];
#pragma unroll
        for (int i = 0; i < 4; ++i) { hv[i] = p[F.lane + 64 * i]; ya[i] = y0[F.lane + 64 * i]; yb[i] = y1[F.lane + 64 * i]; }
#pragma unroll
        for (int i = 0; i < 4; ++i) {
            const unsigned hw[4] = {hv[i].x, hv[i].y, hv[i].z, hv[i].w}; const unsigned aw[2] = {ya[i].x, ya[i].y}, bw[2] = {yb[i].x, yb[i].y};
#define CMB_PAIR(k, HI) do { const pg8::f32x2c a = __builtin_amdgcn_cvt_pk_f32_fp8((int)aw[(k) >> 1], HI), b = __builtin_amdgcn_cvt_pk_f32_fp8((int)bw[(k) >> 1], HI); \
                v[i][2 * (k)] = bflo(hw[k]) + g0 * a[0] + g1 * b[0]; v[i][2 * (k) + 1] = bfhi(hw[k]) + g0 * a[1] + g1 * b[1]; \
                ss += v[i][2 * (k)] * v[i][2 * (k)] + v[i][2 * (k) + 1] * v[i][2 * (k) + 1]; } while (0)
            CMB_PAIR(0, false); CMB_PAIR(1, true); CMB_PAIR(2, false); CMB_PAIR(3, true);
#undef CMB_PAIR
        }
        ss = wave_sum(ss); const float rstd = rsqrtf(ss * (1.0f / DM) + RMS_EPS);
#pragma unroll
        for (int i = 0; i < 4; ++i) { const float4 ga = ((const float4*)w)[2 * (F.lane + 64 * i)], gb = ((const float4*)w)[2 * (F.lane + 64 * i) + 1];
            const float n[8] = {v[i][0] * rstd * ga.x, v[i][1] * rstd * ga.y, v[i][2] * rstd * ga.z, v[i][3] * rstd * ga.w, v[i][4] * rstd * gb.x, v[i][5] * rstd * gb.y, v[i][6] * rstd * gb.z, v[i][7] * rstd * gb.w};
            if (FINAL) { float4* op = (float4*)(OUT + (size_t)row * DM) + 2 * (F.lane + 64 * i); op[0] = make_float4(n[0], n[1], n[2], n[3]); op[1] = make_float4(n[4], n[5], n[6], n[7]); }
            else { u32x4 hw; hw.x = pk2(v[i][0], v[i][1]); hw.y = pk2(v[i][2], v[i][3]); hw.z = pk2(v[i][4], v[i][5]); hw.w = pk2(v[i][6], v[i][7]); ((u32x4*)(H + (size_t)row * DM))[F.lane + 64 * i] = hw;
                static_assert(IN1_FP8, "layer-1 input projection reads e4m3 activations");
                u32x2 o8; o8.x = pk_fp8x4(n[0], n[1], n[2], n[3]); o8.y = pk_fp8x4(n[4], n[5], n[6], n[7]); ((u32x2*)((unsigned char*)(F.ws + WS_HN8) + (size_t)row * DM))[F.lane + 64 * i] = o8; } }
    }
}
constexpr int KT_PITCH = 272, PW_PITCH = 144, TILE_B = 64 * KT_PITCH;
constexpr int AL_KT0 = 0, AL_VT0 = TILE_B, AL_KT1 = 2 * TILE_B, AL_VT1 = 3 * TILE_B, AL_PW = 4 * TILE_B, AL_PWW = 16 * PW_PITCH, AL_Q = AL_PW + NWAVE * AL_PWW, AL_END = AL_Q + 128 * KT_PITCH;
struct TileRegs { u32x4 k[2], v[2]; };
__device__ __forceinline__ void stage_tile(const Frame& F, ldsp dst, const bf16_t* src_row0, int ld, int pos0, int lim) {
#pragma unroll
    for (int i = 0; i < 2; ++i) { const int id = F.tid + NTHR * i, r = id >> 4, ch = id & 15; const int pos = pos0 + r;
        u32x4 v = (u32x4){0u, 0u, 0u, 0u};
        if (pos >= 0 && pos < lim) v = *(const u32x4*)(src_row0 + (unsigned)(r * ld + ch * 8));
        *(LAS u32x4*)(dst + r * KT_PITCH + ch * 16) = v; }
}
template <bool WK, bool WV> __device__ __forceinline__ void tile_prefetch(const Frame& F, const bf16_t* ksrc, const bf16_t* vsrc, int ld, int pos0, int lim, TileRegs& R) {
#pragma unroll
    for (int i = 0; i < 2; ++i) { const int id = F.tid + NTHR * i, r = id >> 4, ch = id & 15; const int pos = pos0 + r; const bool ok = (pos >= 0 && pos < lim);
        R.k[i] = (u32x4){0u, 0u, 0u, 0u}; R.v[i] = (u32x4){0u, 0u, 0u, 0u};
        if (WK && ok) R.k[i] = *(const u32x4*)(ksrc + (unsigned)(r * ld + ch * 8));
        if (WV && ok) R.v[i] = *(const u32x4*)(vsrc + (unsigned)(r * ld + ch * 8)); }
}
template <bool WK, bool WV> __device__ __forceinline__ void tile_commit(const Frame& F, ldsp KT, ldsp VT, const TileRegs& R) {
#pragma unroll
    for (int i = 0; i < 2; ++i) { const int id = F.tid + NTHR * i, r = id >> 4, ch = id & 15;
        if (WK) *(LAS u32x4*)(KT + r * KT_PITCH + ch * 16) = R.k[i];
        if (WV) *(LAS u32x4*)(VT + r * KT_PITCH + ch * 16) = R.v[i]; }
}
__device__ __forceinline__ void tr_frag4(unsigned a, unsigned b, unsigned c_, unsigned d, int rs, bf16x8& ra, bf16x8& rb, bf16x8& rc, bf16x8& rd) {
    s16x4 l0, h0, l1, h1, l2, h2, l3, h3; const unsigned a1 = a + 4 * rs, b1 = b + 4 * rs, c1 = c_ + 4 * rs, d1 = d + 4 * rs;
    asm volatile("ds_read_b64_tr_b16 %0, %8\n\tds_read_b64_tr_b16 %1, %9\n\tds_read_b64_tr_b16 %2, %10\n\tds_read_b64_tr_b16 %3, %11\n\t"
                 "ds_read_b64_tr_b16 %4, %12\n\tds_read_b64_tr_b16 %5, %13\n\tds_read_b64_tr_b16 %6, %14\n\tds_read_b64_tr_b16 %7, %15\n\ts_waitcnt lgkmcnt(0)"
                 : "=&v"(l0), "=&v"(h0), "=&v"(l1), "=&v"(h1), "=&v"(l2), "=&v"(h2), "=&v"(l3), "=&v"(h3) : "v"(a), "v"(a1), "v"(b), "v"(b1), "v"(c_), "v"(c1), "v"(d), "v"(d1) : "memory");
    ra[0] = l0[0]; ra[1] = l0[1]; ra[2] = l0[2]; ra[3] = l0[3]; ra[4] = h0[0]; ra[5] = h0[1]; ra[6] = h0[2]; ra[7] = h0[3];
    rb[0] = l1[0]; rb[1] = l1[1]; rb[2] = l1[2]; rb[3] = l1[3]; rb[4] = h1[0]; rb[5] = h1[1]; rb[6] = h1[2]; rb[7] = h1[3];
    rc[0] = l2[0]; rc[1] = l2[1]; rc[2] = l2[2]; rc[3] = l2[3]; rc[4] = h2[0]; rc[5] = h2[1]; rc[6] = h2[2]; rc[7] = h2[3];
    rd[0] = l3[0]; rd[1] = l3[1]; rd[2] = l3[2]; rd[3] = l3[3]; rd[4] = h3[0]; rd[5] = h3[1]; rd[6] = h3[2]; rd[7] = h3[3];
}
__device__ __forceinline__ void stage_q(const Frame& F, const bf16_t* qbase) {
#pragma unroll
    for (int i = 0; i < 4; ++i) { const int id = F.tid + NTHR * i, row = id >> 4, ch = id & 15;
        *(LAS u32x4*)(F.lds + AL_Q + row * KT_PITCH + ch * 16) = *(const u32x4*)(qbase + (unsigned)((row >> 2) * LDP + (row & 3) * 128 + ch * 8)); }
}
__device__ __forceinline__ void mb_scores(const Frame& F, ldsp KT, f32x4 (&s)[4]) {
    const int c = F.lane & 15, kg = F.lane >> 4; bf16x8 qa[4];
#pragma unroll
    for (int ks = 0; ks < 4; ++ks) qa[ks] = *(LAS bf16x8*)(F.lds + AL_Q + (16 * F.wave + c) * KT_PITCH + (32 * ks + 8 * kg) * 2);
#pragma unroll
    for (int nb = 0; nb < 4; ++nb) { s[nb] = (f32x4){0.f, 0.f, 0.f, 0.f};
#pragma unroll
        for (int ks = 0; ks < 4; ++ks) { const bf16x8 kb = *(LAS bf16x8*)(KT + (16 * nb + c) * KT_PITCH + (32 * ks + 8 * kg) * 2); s[nb] = mfma16(qa[ks], kb, s[nb]); } }
}
__device__ __forceinline__ void tile_pv_lds(const Frame& F, ldsp VT, ldsp PWw, f32x4 (&o)[8]) {
    const int c = F.lane & 15, g4 = F.lane >> 4;
    LDS_FENCE();
    const unsigned vbase = lds_addr(VT) + tr_lane_off(F.lane, KT_PITCH);
#pragma unroll
    for (int ks = 0; ks < 2; ++ks) { const bf16x8 pa = *(LAS bf16x8*)(PWw + c * PW_PITCH + (32 * ks + 8 * g4) * 2);
#pragma unroll
        for (int ne = 0; ne < 8; ne += 2) { bf16x8 v0, v1; const unsigned vb = vbase + 32 * ks * KT_PITCH + 32 * ne; tr_frag2(vb, vb + 32, KT_PITCH, v0, v1);
            o[ne] = mfma16(pa, v0, o[ne]); o[ne + 1] = mfma16(pa, v1, o[ne + 1]); } }
    LDS_FENCE();
}
template <class MaskF> __device__ __forceinline__ void attn_tile(const Frame& F, ldsp KT, ldsp VT, ldsp PWw, f32x4 (&o)[8], float (&m)[4], float (&z)[4], float scale2, MaskF mask) {
    const int c = F.lane & 15, g4 = F.lane >> 4, q = 4 * F.wave + g4; f32x4 s[4]; mb_scores(F, KT, s);
    bool ok[4];
#pragma unroll
    for (int nb = 0; nb < 4; ++nb) ok[nb] = mask(q, 16 * nb + c);
#pragma unroll
    for (int j = 0; j < 4; ++j) { float mx = -INFINITY;
#pragma unroll
        for (int nb = 0; nb < 4; ++nb) { const float v = ok[nb] ? s[nb][j] * scale2 : -INFINITY; s[nb][j] = v; mx = fmaxf(mx, v); }
        mx = grp16_max(mx); const float mo = m[j], mn = fmaxf(mo, mx), mu = (mn == -INFINITY) ? 0.f : mn, al = __builtin_amdgcn_exp2f(mo - mu); float rs = 0.f;
#pragma unroll
        for (int nb = 0; nb < 4; ++nb) { const float p = __builtin_amdgcn_exp2f(s[nb][j] - mu); rs += p; s[nb][j] = p; }
        rs = grp16_sum(rs); z[j] = z[j] * al + rs; m[j] = mn;
#pragma unroll
        for (int ne = 0; ne < 8; ++ne) o[ne][j] *= al; }
#pragma unroll
    for (int nb = 0; nb < 4; ++nb) {
        const unsigned p01 = cvt_pk_bf16(s[nb][0], s[nb][1]), p23 = cvt_pk_bf16(s[nb][2], s[nb][3]);
        ldsp pw = PWw + (4 * g4) * PW_PITCH + (16 * nb + c) * 2;
        *(LAS bf16_t*)(pw) = (bf16_t)(p01 & 0xffffu); *(LAS bf16_t*)(pw + PW_PITCH) = (bf16_t)(p01 >> 16);
        *(LAS bf16_t*)(pw + 2 * PW_PITCH) = (bf16_t)(p23 & 0xffffu); *(LAS bf16_t*)(pw + 3 * PW_PITCH) = (bf16_t)(p23 >> 16); }
    tile_pv_lds(F, VT, PWw, o);
}
__device__ __forceinline__ float rowgrp_max(float v) { v = fmaxf(v, __shfl_xor(v, 16)); v = fmaxf(v, __shfl_xor(v, 32)); return v; }
__device__ __forceinline__ float rowgrp_sum(float v) { v += __shfl_xor(v, 16); v += __shfl_xor(v, 32); return v; }
__device__ __forceinline__ void tr_frag2s(unsigned a, unsigned b, int d1, bf16x8& ra, bf16x8& rb) {
    s16x4 l0, h0, l1, h1; const unsigned a1 = a + d1, b1 = b + d1;
    asm volatile("ds_read_b64_tr_b16 %0, %4\n\tds_read_b64_tr_b16 %1, %5\n\tds_read_b64_tr_b16 %2, %6\n\tds_read_b64_tr_b16 %3, %7\n\ts_waitcnt lgkmcnt(0)"
                 : "=&v"(l0), "=&v"(h0), "=&v"(l1), "=&v"(h1) : "v"(a), "v"(a1), "v"(b), "v"(b1) : "memory");
    ra[0] = l0[0]; ra[1] = l0[1]; ra[2] = l0[2]; ra[3] = l0[3]; ra[4] = h0[0]; ra[5] = h0[1]; ra[6] = h0[2]; ra[7] = h0[3];
    rb[0] = l1[0]; rb[1] = l1[1]; rb[2] = l1[2]; rb[3] = l1[3]; rb[4] = h1[0]; rb[5] = h1[1]; rb[6] = h1[2]; rb[7] = h1[3];
}
template <class MaskF> __device__ __forceinline__ void attn_tile_sw(const Frame& F, ldsp KT, ldsp VT, f32x4 (&o)[8], float& m, float& z, float scale2, MaskF mask) {
    const int c = F.lane & 15, g4 = F.lane >> 4, q = 4 * F.wave + (c >> 2);
    f32x4 s[4];
    { bf16x8 qa[4];
#pragma unroll
      for (int ks = 0; ks < 4; ++ks) qa[ks] = *(LAS bf16x8*)(F.lds + AL_Q + (16 * F.wave + c) * KT_PITCH + (32 * ks + 8 * g4) * 2);
#pragma unroll
      for (int nb = 0; nb < 4; ++nb) { s[nb] = (f32x4){0.f, 0.f, 0.f, 0.f};
#pragma unroll
          for (int ks = 0; ks < 4; ++ks) { const bf16x8 kb = *(LAS bf16x8*)(KT + (16 * nb + c) * KT_PITCH + (32 * ks + 8 * g4) * 2); s[nb] = mfma16(kb, qa[ks], s[nb]); } } }
    float mx = -INFINITY;
#pragma unroll
    for (int nb = 0; nb < 4; ++nb)
#pragma unroll
        for (int j = 0; j < 4; ++j) { const float v = mask(q, 16 * nb + 4 * g4 + j) ? s[nb][j] * scale2 : -INFINITY; s[nb][j] = v; mx = fmaxf(mx, v); }
    mx = rowgrp_max(mx);
    const float mo = m, mn = fmaxf(mo, mx), mu = (mn == -INFINITY) ? 0.f : mn, al = __builtin_amdgcn_exp2f(mo - mu); float rs = 0.f;
#pragma unroll
    for (int nb = 0; nb < 4; ++nb)
#pragma unroll
        for (int j = 0; j < 4; ++j) { const float p = __builtin_amdgcn_exp2f(s[nb][j] - mu); s[nb][j] = p; rs += p; }
    rs = rowgrp_sum(rs); z = z * al + rs; m = mn;
#pragma unroll
    for (int j = 0; j < 4; ++j) { const float aj = __shfl(al, (F.lane & 48) | (4 * g4 + j));
#pragma unroll
        for (int ne = 0; ne < 8; ++ne) o[ne][j] *= aj; }
    const unsigned vbase = lds_addr(VT) + (unsigned)((4 * g4 + (c >> 2)) * KT_PITCH + (c & 3) * 8);
#pragma unroll
    for (int ks = 0; ks < 2; ++ks) { bf16x8 pa; { const unsigned w0 = cvt_pk_bf16(s[2 * ks][0], s[2 * ks][1]), w1 = cvt_pk_bf16(s[2 * ks][2], s[2 * ks][3]), w2 = cvt_pk_bf16(s[2 * ks + 1][0], s[2 * ks + 1][1]), w3 = cvt_pk_bf16(s[2 * ks + 1][2], s[2 * ks + 1][3]);
            const u32x4 pw = (u32x4){w0, w1, w2, w3}; pa = __builtin_bit_cast(bf16x8, pw); }
#pragma unroll
        for (int ne = 0; ne < 8; ne += 2) { bf16x8 v0, v1; const unsigned vb = vbase + 32 * ks * KT_PITCH + 32 * ne; tr_frag2s(vb, vb + 32, 16 * KT_PITCH, v0, v1);
            o[ne] = mfma16(pa, v0, o[ne]); o[ne + 1] = mfma16(pa, v1, o[ne + 1]); } }
}
template <bool WK, bool WV, class GetF, class BodyF> __device__ __forceinline__ void tile_pipeline(const Frame& F, int ntile, int ld, int lim, GetF get, BodyF body) {
    if (ntile <= 0) return;
    TileRegs R; const bf16_t* kp; const bf16_t* vp; int pos0;
    __syncthreads();
    get(0, kp, vp, pos0); tile_prefetch<WK, WV>(F, kp, vp, ld, pos0, lim, R); tile_commit<WK, WV>(F, F.lds + AL_KT0, F.lds + AL_VT0, R);
    __syncthreads();
    for (int i = 0; i < ntile; ++i) {
        const int cb = i & 1; const bool more = (i + 1 < ntile);
        if (more) { get(i + 1, kp, vp, pos0); tile_prefetch<WK, WV>(F, kp, vp, ld, pos0, lim, R); }
        body(i, F.lds + (cb ? AL_KT1 : AL_KT0), F.lds + (cb ? AL_VT1 : AL_VT0));
        if (more) tile_commit<WK, WV>(F, F.lds + (cb ? AL_KT0 : AL_KT1), F.lds + (cb ? AL_VT0 : AL_VT1), R);
        __syncthreads();
    }
}

__device__ __forceinline__ void swa_phase(const Frame& F0) { PHASE_FRAME(F0);
    const bf16_t* PROJ = (const bf16_t*)(F.ws + WS_PROJ); bf16_t* MIX = (bf16_t*)(F.ws + WS_MIX);
    ldsp PWw = F.lds + AL_PW + F.wave * AL_PWW;
    const float scale2 = 0.08838834764831845f * LOG2E;
    const int c = F.lane & 15, g4 = F.lane >> 4;
    for (int k = 0; k * F.G + F.bid < 2048; ++k) {
        const int ui = k * F.G + F.bid, kk = ui >> 8, bg = ((ui & 7) + 8 * (kk >> 2)) & 15, qb = (((ui >> 3) & 31) + 32 * (kk & 3)) & 127;
        const int b = bg >> 1, g = bg & 1, start = qb * 32, cur = qb >> 1; const size_t row0 = (size_t)b * SEQ + start;
        __syncthreads(); stage_q(F, PROJ + row0 * LDP + C_SQ + g * 512);
        f32x4 o[8];
#pragma unroll
        for (int ne = 0; ne < 8; ++ne) o[ne] = (f32x4){0.f, 0.f, 0.f, 0.f};
        float msw = F.in[8][g * 4 + (c & 3)] * LOG2E, zsw = 1.f;
        const int t0 = cur >= 2 ? cur - 2 : 0, nt = cur - t0 + 1;
        const bf16_t* kb = PROJ + (size_t)b * SEQ * LDP + C_SK + g * 128; const bf16_t* vbp = PROJ + (size_t)b * SEQ * LDP + C_SV + g * 128;
        tile_pipeline<true, true>(F, nt, LDP, SEQ,
            [&](int ti, const bf16_t*& kp, const bf16_t*& vp, int& pos0) { pos0 = (t0 + ti) * 64; kp = kb + (size_t)pos0 * LDP; vp = vbp + (size_t)pos0 * LDP; },
            [&](int ti, ldsp KT, ldsp VT) { const int pos0 = (t0 + ti) * 64;
                (void)PWw; attn_tile_sw(F, KT, VT, o, msw, zsw, scale2, [&](int q, int col) { const int rel = (start + q) - (pos0 + col); return rel >= 0 && rel < 128; }); });
#pragma unroll
        for (int j = 0; j < 4; ++j) { const float inv = 1.0f / __shfl(zsw, (F.lane & 48) | (4 * g4 + j)); bf16_t* orow = MIX + row0 * DM + 1024 + (g * 4 + j) * 128; const unsigned oo = (unsigned)((4 * F.wave + g4) * DM + c);
            unsigned char* orow8 = (unsigned char*)(F.ws + WS_MIX8) + row0 * DM + 1024 + (g * 4 + j) * 128;
#pragma unroll
            for (int ne = 0; ne < 8; ++ne) { if constexpr (OUT_FP8) orow8[oo + 16 * ne] = f2fp8(o[ne][j] * inv * ACT8_SCALE); else orow[oo + 16 * ne] = f2bf(o[ne][j] * inv); } }
    }
    __syncthreads();
}

constexpr int HS_G = 0, HS_KT = 4096, HS_VT = HS_KT + 128 * 144;
__device__ __forceinline__ void hgrn_s1_phase(const Frame& F0) { PHASE_FRAME(F0);
    const bf16_t* PROJ = (const bf16_t*)(F.ws + WS_PROJ); const float* LB = (const float*)(F.ws + WS_LB);
    bf16_t* DS = (bf16_t*)(F.ws + WS_DS); float* DEC = (float*)(F.ws + WS_DEC);
    const int dp = F.lane, sg = F.wave, c = F.lane & 15, g4 = F.lane >> 4;
    LAS float* GT = (LAS float*)(F.lds + HS_G);
    unsigned nzf[8], nzv[8];
    auto s1_load = [&](int u) { const int b = u >> 9, h = (u >> 6) & 7, n = u & 63; const size_t r0 = (size_t)b * SEQ + n * 64;
#pragma unroll
        for (int j = 0; j < 8; ++j) { const bf16_t* rp = PROJ + (r0 + 8 * sg + j) * LDP + h * 128 + 2 * dp; nzf[j] = *(const unsigned*)(rp + C_HF); nzv[j] = *(const unsigned*)(rp + C_HI); } };
    if (F.bid < 4096) s1_load(F.bid);
    for (int u = F.bid; u < 4096; u += F.G) {
        const int b = u >> 9, h = (u >> 6) & 7, n = u & 63; const size_t r0 = (size_t)b * SEQ + n * 64; (void)r0; (void)b; (void)n;
        const float lb0 = LB[h * 128 + 2 * dp], lb1 = LB[h * 128 + 2 * dp + 1];
        unsigned zf[8], zv[8];
#pragma unroll
        for (int j = 0; j < 8; ++j) { zf[j] = nzf[j]; zv[j] = nzv[j]; }
        float c0[8], c1[8], k0[8], k1[8]; float a0 = 0.f, a1 = 0.f;
#pragma unroll
        for (int j = 0; j < 8; ++j) { const float s0 = sigmoidf_(bflo(zf[j])), s1 = sigmoidf_(bfhi(zf[j]));
            a0 += __logf(lb0 + (1.f - lb0) * s0); a1 += __logf(lb1 + (1.f - lb1) * s1); c0[j] = a0; c1[j] = a1; k0[j] = (1.f - lb0) * (1.f - s0); k1[j] = (1.f - lb1) * (1.f - s1); }
        GT[sg * 128 + 2 * dp] = a0; GT[sg * 128 + 2 * dp + 1] = a1;
        __syncthreads();
        float pre0 = 0.f, pre1 = 0.f, tot0 = 0.f, tot1 = 0.f;
#pragma unroll
        for (int s = 0; s < 8; ++s) { const float x0 = GT[s * 128 + 2 * dp], x1 = GT[s * 128 + 2 * dp + 1]; if (s < sg) { pre0 += x0; pre1 += x1; } tot0 += x0; tot1 += x1; }
        float e0[8], e1[8];
#pragma unroll
        for (int j = 0; j < 8; ++j) { e0[j] = k0[j] * __expf(tot0 - (pre0 + c0[j])); e1[j] = k1[j] * __expf(tot1 - (pre1 + c1[j])); }
        u32x4 w0, w1, v0, v1;
        w0.x = pk2(e0[0], e0[1]); w0.y = pk2(e0[2], e0[3]); w0.z = pk2(e0[4], e0[5]); w0.w = pk2(e0[6], e0[7]);
        w1.x = pk2(e1[0], e1[1]); w1.y = pk2(e1[2], e1[3]); w1.z = pk2(e1[4], e1[5]); w1.w = pk2(e1[6], e1[7]);
        v0.x = (zv[0] & 0xffffu) | (zv[1] << 16); v0.y = (zv[2] & 0xffffu) | (zv[3] << 16); v0.z = (zv[4] & 0xffffu) | (zv[5] << 16); v0.w = (zv[6] & 0xffffu) | (zv[7] << 16);
        v1.x = (zv[0] >> 16) | (zv[1] & 0xffff0000u); v1.y = (zv[2] >> 16) | (zv[3] & 0xffff0000u); v1.z = (zv[4] >> 16) | (zv[5] & 0xffff0000u); v1.w = (zv[6] >> 16) | (zv[7] & 0xffff0000u);
        *(LAS u32x4*)(F.lds + HS_KT + (2 * dp) * 144 + 16 * sg) = w0; *(LAS u32x4*)(F.lds + HS_KT + (2 * dp + 1) * 144 + 16 * sg) = w1;
        *(LAS u32x4*)(F.lds + HS_VT + (2 * dp) * 144 + 16 * sg) = v0; *(LAS u32x4*)(F.lds + HS_VT + (2 * dp + 1) * 144 + 16 * sg) = v1;
        if (sg == 0) { DEC[(size_t)u * 128 + 2 * dp] = __expf(tot0); DEC[(size_t)u * 128 + 2 * dp + 1] = __expf(tot1); }
        if (u + F.G < 4096) s1_load(u + F.G);
        __syncthreads();
        f32x4 acc[8];
#pragma unroll
        for (int nb = 0; nb < 8; ++nb) acc[nb] = (f32x4){0.f, 0.f, 0.f, 0.f};
#pragma unroll
        for (int ks = 0; ks < 2; ++ks) { const bf16x8 va = *(LAS bf16x8*)(F.lds + HS_VT + (16 * F.wave + c) * 144 + (32 * ks + 8 * g4) * 2);
#pragma unroll
            for (int nb = 0; nb < 8; ++nb) { const bf16x8 kb = *(LAS bf16x8*)(F.lds + HS_KT + (16 * nb + c) * 144 + (32 * ks + 8 * g4) * 2); acc[nb] = mfma16(kb, va, acc[nb]); } }
        bf16_t* dst = DS + (size_t)u * 16384;
#pragma unroll
        for (int nb = 0; nb < 8; ++nb) { u32x2 o; o.x = pk2(acc[nb][0], acc[nb][1]); o.y = pk2(acc[nb][2], acc[nb][3]); *(u32x2*)(dst + (16 * F.wave + c) * 128 + 16 * nb + 4 * g4) = o; }
        __syncthreads();
    }
}
__device__ __forceinline__ void hgrn_scan_phase(const Frame& F0) { PHASE_FRAME(F0);
    const bf16_t* DS = (const bf16_t*)(F.ws + WS_DS); const float* DEC = (const float*)(F.ws + WS_DEC); bf16_t* SP = (bf16_t*)(F.ws + WS_SPREV);
    for (int item = F.bid * NTHR + F.tid; item < 64 * 4096; item += F.G * NTHR) {
        const int bh = item >> 12, q4 = item & 4095, d0 = (4 * q4) & 127;
        float4 st = make_float4(0.f, 0.f, 0.f, 0.f);
#pragma unroll 8
        for (int n = 0; n < 64; ++n) { const size_t u = (size_t)bh * 64 + n;
            const u32x2 dsw = *(const u32x2*)(DS + u * 16384 + 4 * q4); const float4 ds = make_float4(bflo(dsw.x), bfhi(dsw.x), bflo(dsw.y), bfhi(dsw.y)), dc = *(const float4*)(DEC + u * 128 + d0);
            u32x2 o; o.x = pk2(st.x, st.y); o.y = pk2(st.z, st.w); *(u32x2*)(SP + u * 16384 + 4 * q4) = o;
            st.x = dc.x * st.x + ds.x; st.y = dc.y * st.y + ds.y; st.z = dc.z * st.z + ds.z; st.w = dc.w * st.w + ds.w; }
    }
}
constexpr int H3_G = 0, H3_QT = 4096, H3_QH = H3_QT + 64 * KT_PITCH, H3_VN = H3_QH + 64 * KT_PITCH, H3_KH = H3_VN + 64 * KT_PITCH, H3_PW = H3_KH + 160 * KT_PITCH, H3_SSQ = H3_PW + NWAVE * 16 * PW_PITCH, H3_END = H3_SSQ + 512;
static_assert(H3_END <= LDS_BYTES - 64, "hgrn s3 LDS");
__device__ __forceinline__ void hgrn_s3_phase(const Frame& F0) { PHASE_FRAME(F0);
    const bf16_t* PROJ = (const bf16_t*)(F.ws + WS_PROJ); const float* LB = (const float*)(F.ws + WS_LB); const bf16_t* SP = (const bf16_t*)(F.ws + WS_SPREV); bf16_t* MIX = (bf16_t*)(F.ws + WS_MIX);
    const int dp = F.lane, sg = F.wave, c = F.lane & 15, g4 = F.lane >> 4;
    LAS float* GT = (LAS float*)(F.lds + H3_G); LAS float* SSQ = (LAS float*)(F.lds + H3_SSQ);
    unsigned nzf[8], nzq[8]; u32x4 nvt[2];
    auto s3_load = [&](int u) { const int b = u >> 9, h = (u >> 6) & 7, n = u & 63; const size_t r0 = (size_t)b * SEQ + n * 64;
#pragma unroll
        for (int j = 0; j < 8; ++j) { const bf16_t* rp = PROJ + (r0 + 8 * sg + j) * LDP + h * 128 + 2 * dp; nzf[j] = *(const unsigned*)(rp + C_HF); nzq[j] = *(const unsigned*)(rp + C_HQ); }
#pragma unroll
        for (int i = 0; i < 2; ++i) { const int id = F.tid + NTHR * i, r = id >> 4, ch = id & 15; nvt[i] = *(const u32x4*)(PROJ + r0 * LDP + C_HI + h * 128 + (unsigned)(r * LDP + ch * 8)); } };
    if (F.bid < 4096) s3_load(F.bid);
    for (int u = F.bid; u < 4096; u += F.G) {
        const int b = u >> 9, h = (u >> 6) & 7, n = u & 63; const size_t r0 = (size_t)b * SEQ + n * 64; (void)b; (void)n;
        const float lb0 = LB[h * 128 + 2 * dp], lb1 = LB[h * 128 + 2 * dp + 1];
        unsigned zf[8], zq[8];
#pragma unroll
        for (int j = 0; j < 8; ++j) { zf[j] = nzf[j]; zq[j] = nzq[j]; }
#pragma unroll
        for (int i = 0; i < 2; ++i) { const int id = F.tid + NTHR * i, r = id >> 4, ch = id & 15; *(LAS u32x4*)(F.lds + H3_VN + r * KT_PITCH + ch * 16) = nvt[i]; }
        float c0[8], c1[8], k0[8], k1[8]; float a0 = 0.f, a1 = 0.f;
#pragma unroll
        for (int j = 0; j < 8; ++j) { const float s0 = sigmoidf_(bflo(zf[j])), s1 = sigmoidf_(bfhi(zf[j]));
            a0 += __logf(lb0 + (1.f - lb0) * s0); a1 += __logf(lb1 + (1.f - lb1) * s1); c0[j] = a0; c1[j] = a1; k0[j] = (1.f - lb0) * (1.f - s0); k1[j] = (1.f - lb1) * (1.f - s1); }
        GT[sg * 128 + 2 * dp] = a0; GT[sg * 128 + 2 * dp + 1] = a1;
        __syncthreads();
        float pre0 = 0.f, pre1 = 0.f, rf0[4], rf1[4]; { float x0 = 0.f, x1 = 0.f;
#pragma unroll
            for (int s = 0; s < 8; ++s) { if ((s & 1) == 0) { rf0[s >> 1] = x0; rf1[s >> 1] = x1; } if (s == sg) { pre0 = x0; pre1 = x1; } x0 += GT[s * 128 + 2 * dp]; x1 += GT[s * 128 + 2 * dp + 1]; } }
        const int blk = sg >> 1;
        float rb0 = rf0[0], rb1 = rf1[0];
#pragma unroll
        for (int i = 1; i < 4; ++i) if (i == blk) { rb0 = rf0[i]; rb1 = rf1[i]; }
#pragma unroll
        for (int j = 0; j < 8; ++j) { const int s = 8 * sg + j; const float q0 = bflo(zq[j]), q1 = bfhi(zq[j]), b0 = pre0 + c0[j], b1 = pre1 + c1[j];
            *(LAS unsigned*)(F.lds + H3_QT + s * KT_PITCH + 4 * dp) = pk2(q0 * __expf(b0), q1 * __expf(b1));
            *(LAS unsigned*)(F.lds + H3_QH + s * KT_PITCH + 4 * dp) = pk2(q0 * __expf(b0 - rb0), q1 * __expf(b1 - rb1));
#pragma unroll
            for (int i = 0; i < 4; ++i) if (i >= blk) { const int base = (i == 0) ? 0 : (i == 1) ? 16 : (i == 2) ? 48 : 96;
                *(LAS unsigned*)(F.lds + H3_KH + (base + s) * KT_PITCH + 4 * dp) = pk2(k0[j] * __expf(rf0[i] - b0), k1[j] * __expf(rf1[i] - b1)); } }
        __syncthreads();
        if (u + F.G < 4096) s3_load(u + F.G);
        const int ti = F.wave & 3, eh = F.wave >> 2, kbase = (ti == 0) ? 0 : (ti == 1) ? 16 : (ti == 2) ? 48 : 96;
        bf16x8 sbr[4][4];
        { const bf16_t* sp = SP + (size_t)u * 16384;
#pragma unroll
          for (int ks = 0; ks < 4; ++ks)
#pragma unroll
            for (int ne = 0; ne < 4; ++ne) sbr[ks][ne] = *(const bf16x8*)(sp + (64 * eh + 16 * ne + c) * 128 + 32 * ks + 8 * g4); }
        ldsp PWw = F.lds + H3_PW + F.wave * 16 * PW_PITCH;
        {
            bf16x8 qa[4];
#pragma unroll
            for (int ks = 0; ks < 4; ++ks) qa[ks] = *(LAS bf16x8*)(F.lds + H3_QH + (16 * ti + c) * KT_PITCH + (32 * ks + 8 * g4) * 2);
#pragma unroll
            for (int nb = 0; nb < 4; ++nb) { f32x4 s = (f32x4){0.f, 0.f, 0.f, 0.f};
                if (nb <= ti) {
#pragma unroll
                    for (int ks = 0; ks < 4; ++ks) { const bf16x8 kb = *(LAS bf16x8*)(F.lds + H3_KH + (kbase + 16 * nb + c) * KT_PITCH + (32 * ks + 8 * g4) * 2); s = mfma16(qa[ks], kb, s); }
                }
#pragma unroll
                for (int j = 0; j < 4; ++j) { const float v = (nb < ti || (nb == ti && c <= 4 * g4 + j)) ? s[j] : 0.f; *(LAS bf16_t*)(PWw + (4 * g4 + j) * PW_PITCH + (16 * nb + c) * 2) = f2bf(v); } }
        }
        LDS_FENCE();
        f32x4 o[4];
#pragma unroll
        for (int ne = 0; ne < 4; ++ne) o[ne] = (f32x4){0.f, 0.f, 0.f, 0.f};
        const unsigned vbase = lds_addr(F.lds + H3_VN) + tr_lane_off(F.lane, KT_PITCH) + 128 * eh;
#pragma unroll
        for (int ks = 0; ks < 2; ++ks) { const bf16x8 pa = *(LAS bf16x8*)(PWw + c * PW_PITCH + (32 * ks + 8 * g4) * 2);
#pragma unroll
            for (int ne = 0; ne < 4; ne += 2) { bf16x8 v0, v1; tr_frag2(vbase + 32 * ks * KT_PITCH + 32 * ne, vbase + 32 * ks * KT_PITCH + 32 * (ne + 1), KT_PITCH, v0, v1); o[ne] = mfma16(pa, v0, o[ne]); o[ne + 1] = mfma16(pa, v1, o[ne + 1]); } }
#pragma unroll
        for (int ks = 0; ks < 4; ++ks) { const bf16x8 qa = *(LAS bf16x8*)(F.lds + H3_QT + (16 * ti + c) * KT_PITCH + (32 * ks + 8 * g4) * 2);
#pragma unroll
            for (int ne = 0; ne < 4; ++ne) o[ne] = mfma16(qa, sbr[ks][ne], o[ne]); }
#pragma unroll
        for (int j = 0; j < 4; ++j) { float ss = 0.f;
#pragma unroll
            for (int ne = 0; ne < 4; ++ne) ss += o[ne][j] * o[ne][j];
            ss = grp16_sum(ss); if (c == 0) SSQ[eh * 64 + 16 * ti + 4 * g4 + j] = ss; }
        __syncthreads();
        bf16_t gtv[4][4]; float nw[4];
#pragma unroll
        for (int ne = 0; ne < 4; ++ne) nw[ne] = F.in[7][h * 128 + 64 * eh + 16 * ne + c];
#pragma unroll
        for (int j = 0; j < 4; ++j)
#pragma unroll
            for (int ne = 0; ne < 4; ++ne) gtv[j][ne] = PROJ[(r0 + 16 * ti + 4 * g4 + j) * LDP + C_HG + h * 128 + 64 * eh + 16 * ne + c];
#pragma unroll
        for (int j = 0; j < 4; ++j) { const int t = 16 * ti + 4 * g4 + j; const float rstd = rsqrtf((SSQ[t] + SSQ[64 + t]) * (1.0f / 128.f) + RMS_EPS);
#pragma unroll
            for (int ne = 0; ne < 4; ++ne) { const int e = 64 * eh + 16 * ne + c; const float gt = bf2f(gtv[j][ne]);
                const float val = o[ne][j] * rstd * nw[ne] * gt * sigmoidf_(gt);
                if constexpr (OUT_FP8) ((unsigned char*)(F.ws + WS_MIX8))[(r0 + t) * DM + h * 128 + e] = f2fp8(val * ACT8_SCALE); else MIX[(r0 + t) * DM + h * 128 + e] = f2bf(val); } }
        __syncthreads();
    }
}
__device__ __forceinline__ void rot_sincos(float pos, float theta, float& sn, float& cs) {
    const float ang = pos * theta; double r = (double)ang * 0.15915494309189535; r -= floor(r); const float fr = (float)r;
    sn = __builtin_amdgcn_sinf(fr); cs = __builtin_amdgcn_cosf(fr);
}
__device__ __forceinline__ float ret_log2g(int h) { return log2f(1.0f - exp2f(-5.0f - (float)h)); }
constexpr int RT_KZ = 0, RT_V = 128 * KT_PITCH, RV_PITCH = 528, RT_PW = RT_V + 128 * RV_PITCH, RT_TH = RT_PW + NWAVE * 16 * KT_PITCH, RT_END = RT_TH + 256 + 1024;
static_assert(RT_END <= LDS_BYTES - 64, "retention LDS");
template <class PowF> __device__ __forceinline__ void ret_stage_rot(const Frame& F, ldsp dst, const bf16_t* src_row0, int pos_base, float mul, PowF pw) {
    const int tok = F.tid >> 2, qtr = F.tid & 3; const LAS float* TH = (const LAS float*)(F.lds + RT_TH);
    const bf16_t* rp = src_row0 + (size_t)tok * LDP + 16 * qtr;
    u32x4 a0 = *(const u32x4*)rp, a1 = *(const u32x4*)(rp + 8), b0 = *(const u32x4*)(rp + 64), b1 = *(const u32x4*)(rp + 72);
    unsigned xa[8] = {a0.x, a0.y, a0.z, a0.w, a1.x, a1.y, a1.z, a1.w}, xb[8] = {b0.x, b0.y, b0.z, b0.w, b1.x, b1.y, b1.z, b1.w}, oa[8], ob[8];
    const float sc = mul * pw(tok);
#pragma unroll
    for (int i = 0; i < 8; ++i) { float s0, c0, s1, c1; rot_sincos((float)(pos_base + tok), TH[16 * qtr + 2 * i], s0, c0); rot_sincos((float)(pos_base + tok), TH[16 * qtr + 2 * i + 1], s1, c1);
        const float x1l = bflo(xa[i]), x1h = bfhi(xa[i]), x2l = bflo(xb[i]), x2h = bfhi(xb[i]);
        oa[i] = pk2((x1l * c0 - x2l * s0) * sc, (x1h * c1 - x2h * s1) * sc); ob[i] = pk2((x2l * c0 + x1l * s0) * sc, (x2h * c1 + x1h * s1) * sc); }
    *(LAS u32x4*)(dst + tok * KT_PITCH + 32 * qtr) = (u32x4){oa[0], oa[1], oa[2], oa[3]}; *(LAS u32x4*)(dst + tok * KT_PITCH + 32 * qtr + 16) = (u32x4){oa[4], oa[5], oa[6], oa[7]};
    *(LAS u32x4*)(dst + tok * KT_PITCH + 128 + 32 * qtr) = (u32x4){ob[0], ob[1], ob[2], ob[3]}; *(LAS u32x4*)(dst + tok * KT_PITCH + 128 + 32 * qtr + 16) = (u32x4){ob[4], ob[5], ob[6], ob[7]};
}
__device__ __forceinline__ void ret_stage_v(const Frame& F, ldsp dst, const bf16_t* src_row0) {
#pragma unroll
    for (int i = 0; i < 8; ++i) { const int id = F.tid + NTHR * i, r = id >> 5, ch = id & 31; *(LAS u32x4*)(dst + r * RV_PITCH + ch * 16) = *(const u32x4*)(src_row0 + (size_t)r * LDP + ch * 8); }
}
__device__ __forceinline__ void ret_theta(const Frame& F) { if (F.tid < 64) ((LAS float*)(F.lds + RT_TH))[F.tid] = exp2f(-13.287712379549449f * (float)F.tid * (1.0f / 63.0f)); }
__device__ __forceinline__ void ret_s1_phase(const Frame& F0) { PHASE_FRAME(F0);
    const bf16_t* PROJ = (const bf16_t*)(F.ws + WS_PROJ); bf16_t* KV = (bf16_t*)(F.ws + WS_KV);
    const int c = F.lane & 15, g4 = F.lane >> 4;
    __syncthreads(); ret_theta(F); __syncthreads();
    for (int u = F.bid; u < 1024; u += F.G) {
        const int b = u >> 7, h = (u >> 5) & 3, n = u & 31; const size_t r0 = (size_t)b * SEQ + n * 128; const float l2g = ret_log2g(h);
        ret_stage_rot(F, F.lds + RT_KZ, PROJ + r0 * LDP + C_RK + h * 128, n * 128, 0.08838834764831845f, [&](int tok) { return exp2f(l2g * (float)(127 - tok)); });
        ret_stage_v(F, F.lds + RT_V, PROJ + r0 * LDP + C_RV + h * 256);
        __syncthreads();
        const unsigned vb = lds_addr(F.lds + RT_V) + tr_lane_off(F.lane, RV_PITCH) + 64 * F.wave, kb = lds_addr(F.lds + RT_KZ) + tr_lane_off(F.lane, KT_PITCH);
        bf16_t* dst = KV + (size_t)u * 32768;
#pragma unroll 1
        for (int a = 0; a < 2; ++a) {
            f32x4 acc[8];
#pragma unroll
            for (int nb = 0; nb < 8; ++nb) acc[nb] = (f32x4){0.f, 0.f, 0.f, 0.f};
#pragma unroll
            for (int ks = 0; ks < 4; ++ks) { const bf16x8 va = tr_frag(vb + 32 * ks * RV_PITCH + 32 * a, RV_PITCH);
#pragma unroll
                for (int nb = 0; nb < 8; nb += 2) { bf16x8 k0, k1; tr_frag2(kb + 32 * ks * KT_PITCH + 32 * nb, kb + 32 * ks * KT_PITCH + 32 * (nb + 1), KT_PITCH, k0, k1);
                    acc[nb] = mfma16(k0, va, acc[nb]); acc[nb + 1] = mfma16(k1, va, acc[nb + 1]); } }
#pragma unroll
            for (int nb = 0; nb < 8; ++nb) { u32x2 o; o.x = pk2(acc[nb][0], acc[nb][1]); o.y = pk2(acc[nb][2], acc[nb][3]); *(u32x2*)(dst + (unsigned)((32 * F.wave + 16 * a + c) * 128 + 16 * nb + 4 * g4)) = o; }
        }
        __syncthreads();
    }
}
__device__ __forceinline__ void ret_scan_phase(const Frame& F0) { PHASE_FRAME(F0);
    const bf16_t* KV = (const bf16_t*)(F.ws + WS_KV); bf16_t* RP = (bf16_t*)(F.ws + WS_RPREV);
    for (int item = F.bid * NTHR + F.tid; item < 32 * 8192; item += F.G * NTHR) {
        const int bh = item >> 13, q4 = item & 8191; const float cd = exp2f(128.0f * ret_log2g(bh & 3));
        float4 st = make_float4(0.f, 0.f, 0.f, 0.f);
#pragma unroll 8
        for (int n = 0; n < 32; ++n) { const size_t u = (size_t)bh * 32 + n; const u32x2 kw = *(const u32x2*)(KV + u * 32768 + 4 * q4); const float4 kv = make_float4(bflo(kw.x), bfhi(kw.x), bflo(kw.y), bfhi(kw.y));
            u32x2 o; o.x = pk2(st.x, st.y); o.y = pk2(st.z, st.w); *(u32x2*)(RP + u * 32768 + 4 * q4) = o;
            st.x = cd * st.x + kv.x; st.y = cd * st.y + kv.y; st.z = cd * st.z + kv.z; st.w = cd * st.w + kv.w; }
    }
}
__device__ __forceinline__ void ret_s3_phase(const Frame& F0) { PHASE_FRAME(F0);
    const bf16_t* PROJ = (const bf16_t*)(F.ws + WS_PROJ); const bf16_t* RP = (const bf16_t*)(F.ws + WS_RPREV); bf16_t* MIX = (bf16_t*)(F.ws + WS_MIX);
    const int c = F.lane & 15, g4 = F.lane >> 4; const LAS float* TH = (const LAS float*)(F.lds + RT_TH);
    LAS float* ST = (LAS float*)(F.lds + RT_TH + 256);
    __syncthreads(); ret_theta(F); __syncthreads();
    const int ti = F.wave & 3, eh = F.wave >> 2;
    for (int u = F.bid; u < 1024; u += F.G) {
        const int b = u >> 7, h = (u >> 5) & 3, n = u & 31; const size_t r0 = (size_t)b * SEQ + n * 128; const float l2g = ret_log2g(h);
        ret_stage_rot(F, F.lds + RT_KZ, PROJ + r0 * LDP + C_RK + h * 128, n * 128, 0.08838834764831845f, [&](int tok) { return exp2f(-l2g * (float)tok); });
        ret_stage_v(F, F.lds + RT_V, PROJ + r0 * LDP + C_RV + h * 256);
        __syncthreads();
        ldsp PWw = F.lds + RT_PW + F.wave * 16 * KT_PITCH;
        const bf16_t* rp = RP + (size_t)u * 32768 + (size_t)eh * 128 * 128;
        const float gam = exp2f(l2g);
#pragma unroll 1
        for (int pass = 0; pass < 2; ++pass) {
            const int tb = 4 * pass + ti;
            bf16x8 qf[4];
            { const int t = 16 * tb + c; const bf16_t* qp = PROJ + (r0 + t) * LDP + C_RQ + h * 128; const float sc = exp2f(l2g * (float)t);
#pragma unroll
              for (int ks = 0; ks < 2; ++ks) { const bf16x8 x1 = *(const bf16x8*)(qp + 32 * ks + 8 * g4), x2 = *(const bf16x8*)(qp + 64 + 32 * ks + 8 * g4);
#pragma unroll
                  for (int i = 0; i < 8; ++i) { float sn, cs; rot_sincos((float)(n * 128 + t), TH[32 * ks + 8 * g4 + i], sn, cs); const float a = bf2f((bf16_t)x1[i]), bb = bf2f((bf16_t)x2[i]);
                      qf[ks][i] = (short)f2bf((a * cs - bb * sn) * sc); qf[ks + 2][i] = (short)f2bf((bb * cs + a * sn) * sc); } } }
#pragma unroll
            for (int nb = 0; nb < 8; ++nb) { f32x4 s = (f32x4){0.f, 0.f, 0.f, 0.f};
                if (nb <= tb) {
#pragma unroll
                    for (int ks = 0; ks < 4; ++ks) { const bf16x8 kb = *(LAS bf16x8*)(F.lds + RT_KZ + (16 * nb + c) * KT_PITCH + (32 * ks + 8 * g4) * 2); s = mfma16(qf[ks], kb, s); } }
#pragma unroll
                for (int j = 0; j < 4; ++j) { const float v = (nb < tb || (nb == tb && c <= 4 * g4 + j)) ? s[j] : 0.f; *(LAS bf16_t*)(PWw + (4 * g4 + j) * KT_PITCH + (16 * nb + c) * 2) = f2bf(v); } }
            LDS_FENCE();
            f32x4 o[8];
#pragma unroll
            for (int ne = 0; ne < 8; ++ne) o[ne] = (f32x4){0.f, 0.f, 0.f, 0.f};
#pragma unroll
            for (int ks = 0; ks < 4; ++ks)
#pragma unroll
                for (int ne = 0; ne < 8; ++ne) { const bf16x8 rb = *(const bf16x8*)(rp + (unsigned)((16 * ne + c) * 128 + 32 * ks + 8 * g4)); o[ne] = mfma16(qf[ks], rb, o[ne]); }
#pragma unroll
            for (int ne = 0; ne < 8; ++ne) o[ne] *= gam;
            const unsigned vb = lds_addr(F.lds + RT_V) + tr_lane_off(F.lane, RV_PITCH) + 256 * eh;
#pragma unroll
            for (int ks = 0; ks < 4; ++ks) { const bf16x8 pa = *(LAS bf16x8*)(PWw + c * KT_PITCH + (32 * ks + 8 * g4) * 2);
#pragma unroll
                for (int ne = 0; ne < 8; ne += 2) { bf16x8 v0, v1; tr_frag2(vb + 32 * ks * RV_PITCH + 32 * ne, vb + 32 * ks * RV_PITCH + 32 * (ne + 1), RV_PITCH, v0, v1); o[ne] = mfma16(pa, v0, o[ne]); o[ne + 1] = mfma16(pa, v1, o[ne + 1]); } }
#pragma unroll
            for (int j = 0; j < 4; ++j) { float sm = 0.f, sq = 0.f;
#pragma unroll
                for (int ne = 0; ne < 8; ++ne) { sm += o[ne][j]; sq += o[ne][j] * o[ne][j]; }
                sm = grp16_sum(sm); sq = grp16_sum(sq);
                if (c == 0) { ST[(eh * 64 + 16 * ti + 4 * g4 + j) * 2] = sm; ST[(eh * 64 + 16 * ti + 4 * g4 + j) * 2 + 1] = sq; } }
            __syncthreads();
            const bf16_t* gp = PROJ + r0 * LDP + C_RG + h * 256 + 128 * eh; bf16_t* mp = MIX + r0 * DM + 1024 + h * 256 + 128 * eh; const float* np_ = F.in[17] + h * 256 + 128 * eh;
            float nw[8];
#pragma unroll
            for (int ne = 0; ne < 8; ++ne) nw[ne] = np_[16 * ne + c];
#pragma unroll
            for (int j = 0; j < 4; ++j) { const int rl64 = 16 * ti + 4 * g4 + j; const float sm = ST[rl64 * 2] + ST[(64 + rl64) * 2], sq = ST[rl64 * 2 + 1] + ST[(64 + rl64) * 2 + 1];
                const float mean = sm * (1.0f / 256.f), rstd = rsqrtf(fmaxf(sq * (1.0f / 256.f) - mean * mean, 0.f) + RMS_EPS); const unsigned rl = (unsigned)(16 * tb + 4 * g4 + j);
                bf16_t gtv[8];
#pragma unroll
                for (int ne = 0; ne < 8; ++ne) gtv[ne] = gp[rl * LDP + 16 * ne + c];
#pragma unroll
                for (int ne = 0; ne < 8; ++ne) { const unsigned e = 16 * ne + c; const float gt = bf2f(gtv[ne]);
                    const float val = (o[ne][j] - mean) * rstd * nw[ne] * gt * sigmoidf_(gt);
                    if constexpr (OUT_FP8) *(LAS unsigned char*)(PWw + (4 * g4 + j) * KT_PITCH + e) = f2fp8(val * ACT8_SCALE); else mp[rl * DM + e] = f2bf(val); } }
            if constexpr (OUT_FP8) {
                LDS_FENCE();
                unsigned char* ob = (unsigned char*)(F.ws + WS_MIX8) + r0 * DM + 1024 + h * 256 + 128 * eh;
#pragma unroll
                for (int i = 0; i < 2; ++i) { const int rr = F.lane >> 2, ch = (F.lane & 3) * 2 + i; const u32x4 w = *(LAS u32x4*)(PWw + rr * KT_PITCH + ch * 16);
                    *(u32x4*)(ob + (unsigned)((16 * tb + rr) * DM + ch * 16)) = w; } }
            __syncthreads();
        }
    }
}

__device__ __forceinline__ float gelu_tanh(float x) { const float y = 0.7978845608028654f * (x + 0.044715f * x * x * x); return x * (1.0f - __builtin_amdgcn_rcpf(1.0f + __expf(2.0f * y))); }
constexpr int CP_ROWS = 528, CP_H = CP_ROWS * 256;
static_assert(CP_H + 32 * KT_PITCH <= LDS_BYTES - 64, "nsa compress LDS");
__device__ __forceinline__ void nsa_compress_phase(const Frame& F0) { PHASE_FRAME(F0);
    const bf16_t* PROJ = (const bf16_t*)(F.ws + WS_PROJ); bf16_t* KC = (bf16_t*)(F.ws + WS_KCMP);
    const int c = F.lane & 15, g4 = F.lane >> 4;
    for (int u = F.bid; u < 256; u += F.G) {
        const int kv = u >> 7, b = (u >> 4) & 7, g = (u >> 3) & 1, nt = u & 7; const bool ok0 = 32 * nt + c <= 254, ok1 = 32 * nt + 16 + c <= 254;
        const bf16_t* src = PROJ + ((size_t)b * SEQ + 512 * nt) * LDP + (kv ? C_NVC : C_NKC) + g * 128; const int rmax = SEQ - 1 - 512 * nt;
        __syncthreads();
        { u32x4 st[17];
#pragma unroll
          for (int i = 0; i < 17; ++i) { const int id = F.tid + NTHR * i, r = id >> 4, ch = id & 15; const int rr = r < rmax ? r : rmax; st[i] = *(const u32x4*)(src + (unsigned)(rr * LDP + ch * 8)); }
#pragma unroll
          for (int i = 0; i < 17; ++i) { const int id = F.tid + NTHR * i, r = id >> 4, ch = id & 15; if (r < CP_ROWS) *(LAS u32x4*)(F.lds + r * 256 + ((ch ^ ((r >> 4) & 15)) << 4)) = st[i]; } }
        const bf16_t* wp = (const bf16_t*)(F.ws + WS_NW1) + (size_t)kv * 128 * 4096 + (size_t)(16 * F.wave + c) * 4096 + 8 * g4;
        f32x4 acc[2][4];
#pragma unroll
        for (int a = 0; a < 2; ++a)
#pragma unroll
            for (int i = 0; i < 4; ++i) acc[a][i] = (f32x4){0.f, 0.f, 0.f, 0.f};
        __syncthreads();
#pragma unroll 1
        for (int lh = 0; lh < 2; ++lh) {
            const int sw = (c + lh) & 15; const unsigned abase = lds_addr(F.lds) + (unsigned)((16 * c + 16 * lh) * 256);
#pragma unroll 4
            for (int ll = 0; ll < 16; ++ll) {
#pragma unroll
                for (int k4 = 0; k4 < 4; ++k4) { const unsigned ad = abase + ll * 256 + (((4 * k4 + g4) ^ sw) << 4);
                    bf16x8 a0 = *(LAS bf16x8*)(size_t)ad, a1 = *(LAS bf16x8*)(size_t)(ad + 256 * 256);
                    if (!ok0) a0 = (bf16x8){0, 0, 0, 0, 0, 0, 0, 0}; if (!ok1) a1 = (bf16x8){0, 0, 0, 0, 0, 0, 0, 0};
                    const bf16x8 w = *(const bf16x8*)(wp + 128 * (16 * lh + ll) + 32 * k4); acc[0][k4] = mfma16(a0, w, acc[0][k4]); acc[1][k4] = mfma16(a1, w, acc[1][k4]); } } }
        float bias = 0.f; for (int jj = 0; jj < 16; ++jj) bias += ((const float*)(F.ws + WS_NBIAS))[(kv * 16 + jj) * 128 + 16 * F.wave + c];
#pragma unroll
        for (int a = 0; a < 2; ++a) { const f32x4 hs = (acc[a][0] + acc[a][1]) + (acc[a][2] + acc[a][3]);
#pragma unroll
            for (int j = 0; j < 4; ++j) *(LAS bf16_t*)(F.lds + CP_H + (16 * a + 4 * g4 + j) * KT_PITCH + (16 * F.wave + c) * 2) = f2bf(gelu_tanh(hs[j] + bias)); }
        __syncthreads();
        const bf16_t* w2 = (const bf16_t*)(F.ws + WS_NW2) + (size_t)kv * 128 * 128 + (size_t)(16 * F.wave + c) * 128 + 8 * g4;
        f32x4 o[2] = {(f32x4){0.f, 0.f, 0.f, 0.f}, (f32x4){0.f, 0.f, 0.f, 0.f}};
#pragma unroll
        for (int ks = 0; ks < 4; ++ks) { const bf16x8 w = *(const bf16x8*)(w2 + 32 * ks);
#pragma unroll
            for (int a = 0; a < 2; ++a) { const bf16x8 x = *(LAS bf16x8*)(F.lds + CP_H + (16 * a + c) * KT_PITCH + (32 * ks + 8 * g4) * 2); o[a] = mfma16(x, w, o[a]); } }
        bf16_t* dst = KC + ((size_t)(kv * 8 + b) * 2 + g) * 256 * 128;
#pragma unroll
        for (int a = 0; a < 2; ++a)
#pragma unroll
            for (int j = 0; j < 4; ++j) { const int nn = 32 * nt + 16 * a + 4 * g4 + j; dst[nn * 128 + 16 * F.wave + c] = (nn <= 254) ? f2bf(o[a][j]) : (bf16_t)0; }
    }
    __syncthreads();
}
constexpr int N2_Q = 4 * TILE_B, N2_IMP = N2_Q + 256 * KT_PITCH, N2_SEL = N2_IMP + 64 * 64 * 4, N2_LIST = N2_SEL + 512, N2_END = N2_LIST + 64;
static_assert(N2_END <= LDS_BYTES - 64, "nsa LDS");
__device__ __forceinline__ void stage_q2(const Frame& F, const bf16_t* qbase) {
#pragma unroll
    for (int i = 0; i < 8; ++i) { const int id = F.tid + NTHR * i, row = id >> 4, ch = id & 15;
        *(LAS u32x4*)(F.lds + N2_Q + row * KT_PITCH + ch * 16) = *(const u32x4*)(qbase + (unsigned)((row >> 2) * LDP + (row & 3) * 128 + ch * 8)); }
}
__device__ __forceinline__ void scores2(const Frame& F, ldsp KT, f32x4 (&s)[2][4]) {
    const int c = F.lane & 15, g4 = F.lane >> 4;
#pragma unroll
    for (int a = 0; a < 2; ++a)
#pragma unroll
        for (int nb = 0; nb < 4; ++nb) s[a][nb] = (f32x4){0.f, 0.f, 0.f, 0.f};
#pragma unroll
    for (int ks = 0; ks < 4; ++ks) {
        const bf16x8 q0 = *(LAS bf16x8*)(F.lds + N2_Q + (32 * F.wave + c) * KT_PITCH + (32 * ks + 8 * g4) * 2), q1 = *(LAS bf16x8*)(F.lds + N2_Q + (32 * F.wave + 16 + c) * KT_PITCH + (32 * ks + 8 * g4) * 2);
#pragma unroll
        for (int nb = 0; nb < 4; ++nb) { const bf16x8 kb = *(LAS bf16x8*)(KT + (16 * nb + c) * KT_PITCH + (32 * ks + 8 * g4) * 2); s[0][nb] = mfma16(kb, q0, s[0][nb]); s[1][nb] = mfma16(kb, q1, s[1][nb]); } }
}
__device__ __forceinline__ void pv2(const Frame& F, ldsp VT, const f32x4 (&s)[2][4], const float (&pg)[2], f32x4 (&o)[2][8]) {
    const int c = F.lane & 15, g4 = F.lane >> 4;
    const unsigned vbase = lds_addr(VT) + (unsigned)((4 * g4 + (c >> 2)) * KT_PITCH + (c & 3) * 8);
#pragma unroll
    for (int ks = 0; ks < 2; ++ks) { bf16x8 pa[2];
#pragma unroll
        for (int a = 0; a < 2; ++a) { const u32x4 pw = (u32x4){cvt_pk_bf16(s[a][2 * ks][0] * pg[a], s[a][2 * ks][1] * pg[a]), cvt_pk_bf16(s[a][2 * ks][2] * pg[a], s[a][2 * ks][3] * pg[a]),
                                                     cvt_pk_bf16(s[a][2 * ks + 1][0] * pg[a], s[a][2 * ks + 1][1] * pg[a]), cvt_pk_bf16(s[a][2 * ks + 1][2] * pg[a], s[a][2 * ks + 1][3] * pg[a])}; pa[a] = __builtin_bit_cast(bf16x8, pw); }
#pragma unroll
        for (int ne = 0; ne < 8; ne += 2) { bf16x8 v0, v1; const unsigned vb = vbase + 32 * ks * KT_PITCH + 32 * ne; tr_frag2s(vb, vb + 32, 16 * KT_PITCH, v0, v1);
            o[0][ne] = mfma16(pa[0], v0, o[0][ne]); o[1][ne] = mfma16(pa[1], v0, o[1][ne]); o[0][ne + 1] = mfma16(pa[0], v1, o[0][ne + 1]); o[1][ne + 1] = mfma16(pa[1], v1, o[1][ne + 1]); } }
}
template <class MaskF> __device__ __forceinline__ void attn_tile2(const Frame& F, ldsp KT, ldsp VT, f32x4 (&o)[2][8], float (&m)[2], float (&z)[2], float scale2, MaskF mask) {
    const int c = F.lane & 15, g4 = F.lane >> 4; f32x4 s[2][4]; scores2(F, KT, s);
#pragma unroll
    for (int a = 0; a < 2; ++a) { const int q = 8 * F.wave + 4 * a + (c >> 2); float mx = -INFINITY;
#pragma unroll
        for (int nb = 0; nb < 4; ++nb)
#pragma unroll
            for (int j = 0; j < 4; ++j) { const float v = mask(q, 16 * nb + 4 * g4 + j) ? s[a][nb][j] * scale2 : -INFINITY; s[a][nb][j] = v; mx = fmaxf(mx, v); }
        mx = rowgrp_max(mx);
        const float mo = m[a], mn = fmaxf(mo, mx), mu = (mn == -INFINITY) ? 0.f : mn, al = __builtin_amdgcn_exp2f(mo - mu); float rs = 0.f;
#pragma unroll
        for (int nb = 0; nb < 4; ++nb)
#pragma unroll
            for (int j = 0; j < 4; ++j) { const float p = __builtin_amdgcn_exp2f(s[a][nb][j] - mu); s[a][nb][j] = p; rs += p; }
        rs = rowgrp_sum(rs); z[a] = z[a] * al + rs; m[a] = mn;
#pragma unroll
        for (int j = 0; j < 4; ++j) { const float aj = __shfl(al, (F.lane & 48) | (4 * g4 + j));
#pragma unroll
            for (int ne = 0; ne < 8; ++ne) o[a][ne][j] *= aj; } }
    const float one[2] = {1.f, 1.f};
    pv2(F, VT, s, one, o);
}
__device__ __forceinline__ void pl16swap(unsigned& a, unsigned& b) { asm("s_nop 1\n\tv_permlane16_swap_b32 %0, %1" : "+v"(a), "+v"(b)); }
__device__ __forceinline__ void pl32swap(unsigned& a, unsigned& b) { asm("s_nop 1\n\tv_permlane32_swap_b32 %0, %1" : "+v"(a), "+v"(b)); }
__device__ __forceinline__ float xrow_max(float v) { unsigned a = __builtin_bit_cast(unsigned, v), b = a; pl16swap(a, b); const float w = fmaxf(__builtin_bit_cast(float, a), __builtin_bit_cast(float, b));
    a = __builtin_bit_cast(unsigned, w); b = a; pl32swap(a, b); return fmaxf(__builtin_bit_cast(float, a), __builtin_bit_cast(float, b)); }
__device__ __forceinline__ float xrow_sum(float v) { unsigned a = __builtin_bit_cast(unsigned, v), b = a; pl16swap(a, b); const float w = __builtin_bit_cast(float, a) + __builtin_bit_cast(float, b);
    a = __builtin_bit_cast(unsigned, w); b = a; pl32swap(a, b); return __builtin_bit_cast(float, a) + __builtin_bit_cast(float, b); }
template <int KS> __device__ __forceinline__ void rd_qk(unsigned aq, unsigned ak, bf16x8& q0, bf16x8& q1, bf16x8& k0, bf16x8& k1, bf16x8& k2, bf16x8& k3) {
    asm volatile("ds_read_b128 %0, %6 offset:%8\n\tds_read_b128 %1, %6 offset:%9\n\tds_read_b128 %2, %7 offset:%8\n\tds_read_b128 %3, %7 offset:%9\n\tds_read_b128 %4, %7 offset:%10\n\tds_read_b128 %5, %7 offset:%11\n\ts_waitcnt lgkmcnt(0)"
                 : "=&v"(q0), "=&v"(q1), "=&v"(k0), "=&v"(k1), "=&v"(k2), "=&v"(k3) : "v"(aq), "v"(ak), "n"(64 * KS), "n"(16 * KT_PITCH + 64 * KS), "n"(32 * KT_PITCH + 64 * KS), "n"(48 * KT_PITCH + 64 * KS) : "memory");
}
template <int OFF> __device__ __forceinline__ void tr_quad(unsigned vb, bf16x8& r0, bf16x8& r1, bf16x8& r2, bf16x8& r3) {
    s16x4 l0, h0, l1, h1, l2, h2, l3, h3;
    asm volatile("ds_read_b64_tr_b16 %0, %8 offset:%9\n\tds_read_b64_tr_b16 %1, %8 offset:%10\n\tds_read_b64_tr_b16 %2, %8 offset:%11\n\tds_read_b64_tr_b16 %3, %8 offset:%12\n\t"
                 "ds_read_b64_tr_b16 %4, %8 offset:%13\n\tds_read_b64_tr_b16 %5, %8 offset:%14\n\tds_read_b64_tr_b16 %6, %8 offset:%15\n\tds_read_b64_tr_b16 %7, %8 offset:%16\n\ts_waitcnt lgkmcnt(0)"
                 : "=&v"(l0), "=&v"(h0), "=&v"(l1), "=&v"(h1), "=&v"(l2), "=&v"(h2), "=&v"(l3), "=&v"(h3)
                 : "v"(vb), "n"(OFF), "n"(OFF + 16 * KT_PITCH), "n"(OFF + 32), "n"(OFF + 32 + 16 * KT_PITCH), "n"(OFF + 64), "n"(OFF + 64 + 16 * KT_PITCH), "n"(OFF + 96), "n"(OFF + 96 + 16 * KT_PITCH) : "memory");
    r0[0] = l0[0]; r0[1] = l0[1]; r0[2] = l0[2]; r0[3] = l0[3]; r0[4] = h0[0]; r0[5] = h0[1]; r0[6] = h0[2]; r0[7] = h0[3];
    r1[0] = l1[0]; r1[1] = l1[1]; r1[2] = l1[2]; r1[3] = l1[3]; r1[4] = h1[0]; r1[5] = h1[1]; r1[6] = h1[2]; r1[7] = h1[3];
    r2[0] = l2[0]; r2[1] = l2[1]; r2[2] = l2[2]; r2[3] = l2[3]; r2[4] = h2[0]; r2[5] = h2[1]; r2[6] = h2[2]; r2[7] = h2[3];
    r3[0] = l3[0]; r3[1] = l3[1]; r3[2] = l3[2]; r3[3] = l3[3]; r3[4] = h3[0]; r3[5] = h3[1]; r3[6] = h3[2]; r3[7] = h3[3];
}
template <bool A0, bool A1, int MODE> __device__ __forceinline__ void attn_tile3(const Frame& F, ldsp KT, ldsp VT, f32x4 (&o)[2][8], float (&m)[2], float (&z)[2], float scale2, bool rowok0, bool rowok1) {
    const int lane_ = opq(F.lane); const int c = lane_ & 15, g4 = lane_ >> 4; f32x4 s[2][4];
#pragma unroll
    for (int a = 0; a < 2; ++a)
#pragma unroll
        for (int nb = 0; nb < 4; ++nb) s[a][nb] = (f32x4){0.f, 0.f, 0.f, 0.f};
    { const unsigned aq = lds_addr(F.lds + N2_Q + (32 * F.wave + c) * KT_PITCH + 16 * g4), ak = lds_addr(KT + c * KT_PITCH + 16 * g4);
#define T3_KSTEP(KS) do { bf16x8 q0, q1, kf[4]; rd_qk<KS>(aq, ak, q0, q1, kf[0], kf[1], kf[2], kf[3]); _Pragma("unroll") for (int nb = 0; nb < 4; ++nb) { if (A0) s[0][nb] = mfma16(kf[nb], q0, s[0][nb]); if (A1) s[1][nb] = mfma16(kf[nb], q1, s[1][nb]); } } while (0)
      T3_KSTEP(0); T3_KSTEP(1); T3_KSTEP(2); T3_KSTEP(3);
#undef T3_KSTEP
    }
#pragma unroll
    for (int a = 0; a < 2; ++a) { if (!(a ? A1 : A0)) continue;
        const bool rowok = a ? rowok1 : rowok0; const int ql = 8 * F.wave + 4 * a + (c >> 2) - 4 * g4;
        float mx = -INFINITY;
#pragma unroll
        for (int nb = 0; nb < 4; ++nb)
#pragma unroll
            for (int j = 0; j < 4; ++j) { if (MODE == 1) s[a][nb][j] = (16 * nb + j <= ql) ? s[a][nb][j] : -INFINITY; if (MODE == 2) s[a][nb][j] = (16 * nb + j > ql) ? s[a][nb][j] : -INFINITY; mx = fmaxf(mx, s[a][nb][j]); }
        mx = xrow_max(mx); if (!rowok) mx = -INFINITY;
        const float mxs = mx * scale2, mo = m[a]; const bool need = mxs > mo + 8.0f; const float mn = need ? mxs : mo, mu = (mn == -INFINITY) ? 0.f : mn, nmu = rowok ? -mu : -INFINITY; float rs = 0.f;
#pragma unroll
        for (int nb = 0; nb < 4; ++nb)
#pragma unroll
            for (int j = 0; j < 4; ++j) { const float p = __builtin_amdgcn_exp2f(__builtin_fmaf(s[a][nb][j], scale2, nmu)); s[a][nb][j] = p; rs += p; }
        rs = xrow_sum(rs); m[a] = mn;
        if (__ballot(need) != 0ull) { const float al = need ? __builtin_amdgcn_exp2f(mo - mn) : 1.0f; z[a] = z[a] * al + rs;
#pragma unroll
            for (int j = 0; j < 4; ++j) { const float aj = __shfl(al, (lane_ & 48) | (4 * g4 + j));
#pragma unroll
                for (int ne = 0; ne < 8; ++ne) o[a][ne][j] *= aj; } }
        else z[a] += rs; }
    const unsigned vbase = lds_addr(VT) + (unsigned)((4 * g4 + (c >> 2)) * KT_PITCH + (c & 3) * 8);
#pragma unroll
    for (int ks = 0; ks < 2; ++ks) { bf16x8 pa[2];
#pragma unroll
        for (int a = 0; a < 2; ++a) { if (!(a ? A1 : A0)) continue;
            const u32x4 pw = (u32x4){cvt_pk_bf16(s[a][2 * ks][0], s[a][2 * ks][1]), cvt_pk_bf16(s[a][2 * ks][2], s[a][2 * ks][3]), cvt_pk_bf16(s[a][2 * ks + 1][0], s[a][2 * ks + 1][1]), cvt_pk_bf16(s[a][2 * ks + 1][2], s[a][2 * ks + 1][3])}; pa[a] = __builtin_bit_cast(bf16x8, pw); }
#define T3_PV(KS, NE) do { bf16x8 vf[4]; tr_quad<32 * (KS) * KT_PITCH + 32 * (NE)>(vbase, vf[0], vf[1], vf[2], vf[3]); _Pragma("unroll") for (int x = 0; x < 4; ++x) { if (A0) o[0][(NE) + x] = mfma16(pa[0], vf[x], o[0][(NE) + x]); if (A1) o[1][(NE) + x] = mfma16(pa[1], vf[x], o[1][(NE) + x]); } } while (0)
        if (ks == 0) { T3_PV(0, 0); T3_PV(0, 4); } else { T3_PV(1, 0); T3_PV(1, 4); }
#undef T3_PV
    }
}
__device__ __forceinline__ void nsa_attn_phase(const Frame& F0) { PHASE_FRAME(F0);
    const bf16_t* PROJ = (const bf16_t*)(F.ws + WS_PROJ); const bf16_t* KC = (const bf16_t*)(F.ws + WS_KCMP); bf16_t* MIX = (bf16_t*)(F.ws + WS_MIX);
    LAS float* IMP = (LAS float*)(F.lds + N2_IMP); LAS unsigned long long* SEL = (LAS unsigned long long*)(F.lds + N2_SEL); LAS unsigned char* LIST = (LAS unsigned char*)(F.lds + N2_LIST);
    const float scale2 = 0.08838834764831845f * LOG2E;
    const int c = F.lane & 15, g4 = F.lane >> 4;
    for (int k = 0; k * F.G + F.bid < 1024; ++k) {
        F.tid = opq(F.tid); F.lane = F.tid & 63;
        const int c = F.lane & 15, g4 = F.lane >> 4;
        const int ui = k * F.G + F.bid, kk = ui >> 8, bg = ((ui & 7) + 8 * (kk >> 1)) & 15, qx = (ui >> 3) & 31, qb = (kk & 1) ? 63 - qx : qx;
        const int b = bg >> 1, g = bg & 1, start = qb * 64, cur = qb; const size_t row0 = (size_t)b * SEQ + start;
        __syncthreads(); stage_q2(F, PROJ + row0 * LDP + C_NQ + g * 512);
        for (int ii = F.tid; ii < 4096; ii += NTHR) IMP[ii] = 0.f;
        f32x4 o[2][8];
#define N2_ZERO_O() do { _Pragma("unroll") for (int a = 0; a < 2; ++a) _Pragma("unroll") for (int ne = 0; ne < 8; ++ne) o[a][ne] = (f32x4){0.f, 0.f, 0.f, 0.f}; } while (0)
        N2_ZERO_O();
        const bf16_t* gbase = PROJ + row0 * LDP + C_GT;
        bf16_t* const obase = MIX + row0 * DM + g * 512;
        float msw[2], zsw[2];
#define N2_RESET() do { msw[0] = msw[1] = -INFINITY; zsw[0] = zsw[1] = 0.f; N2_ZERO_O(); } while (0)
        for (int rep_ = 0; rep_ < PROBE_B3; ++rep_) {
        N2_RESET();
        { const int t0 = cur >= 8 ? cur - 8 : 0, nt = cur - t0 + 1;
          const bf16_t* kb = PROJ + (size_t)b * SEQ * LDP + C_NKW + g * 128; const bf16_t* vbp = PROJ + (size_t)b * SEQ * LDP + C_NVW + g * 128;
          tile_pipeline<true, true>(F, nt, LDP, SEQ,
            [&](int ti, const bf16_t*& kp, const bf16_t*& vp, int& pos0) { pos0 = (t0 + ti) * 64; kp = kb + (size_t)pos0 * LDP; vp = vbp + (size_t)pos0 * LDP; },
            [&](int ti, ldsp KT, ldsp VT) {
                if (ti == nt - 1) attn_tile3<true, true, 1>(F, KT, VT, o, msw, zsw, scale2, true, true);
                else if (cur >= 8 && ti == 0) attn_tile3<true, true, 2>(F, KT, VT, o, msw, zsw, scale2, true, true);
                else attn_tile3<true, true, 0>(F, KT, VT, o, msw, zsw, scale2, true, true); }); }
        }
        { const int l_ = opq(F.lane); const int g4 = l_ >> 4;
#pragma unroll
          for (int a = 0; a < 2; ++a) { const int qr = 8 * F.wave + 4 * a + g4;
#pragma unroll
            for (int j = 0; j < 4; ++j) { const float zj = __shfl(zsw[a], (l_ & 48) | (4 * g4 + j)); const float gj = sigmoidf_(bf2f(gbase[(unsigned)(qr * LDP + (g * 4 + j) * 3 + 2)])); const float w = zj > 0.f ? gj / zj : 0.f;
#pragma unroll
                for (int ne = 0; ne < 8; ++ne) o[a][ne][j] *= w; } } }
        const int ncmp = min(4 * qb + 3, 255), ntile = (ncmp + 63) >> 6;
        const bf16_t* kc = KC + ((size_t)(0 * 8 + b) * 2 + g) * 256 * 128; const bf16_t* vc = KC + ((size_t)(1 * 8 + b) * 2 + g) * 256 * 128;
        float mc[2] = {-INFINITY, -INFINITY}, zc[2] = {0.f, 0.f};
        auto cmp_mask_scale = [&](int ti, f32x4 (&s)[2][4]) {
#pragma unroll
            for (int a = 0; a < 2; ++a) { const int tq = start + 8 * F.wave + 4 * a + (c >> 2);
#pragma unroll
                for (int nb = 0; nb < 4; ++nb)
#pragma unroll
                    for (int j = 0; j < 4; ++j) { const int nn = 64 * ti + 16 * nb + 4 * g4 + j; s[a][nb][j] = (nn <= 254 && 16 * nn + 31 <= tq) ? s[a][nb][j] * scale2 : -INFINITY; } } };
        tile_pipeline<true, false>(F, ntile, 128, 256,
            [&](int ti, const bf16_t*& kp, const bf16_t*& vp, int& pos0) { pos0 = 64 * ti; kp = kc + (size_t)pos0 * 128; vp = kp; },
            [&](int ti, ldsp KT, ldsp VT) { (void)VT; f32x4 s[2][4]; scores2(F, KT, s); cmp_mask_scale(ti, s);
#pragma unroll
                for (int a = 0; a < 2; ++a) { float mx = -INFINITY;
#pragma unroll
                    for (int nb = 0; nb < 4; ++nb)
#pragma unroll
                        for (int j = 0; j < 4; ++j) mx = fmaxf(mx, s[a][nb][j]);
                    mx = rowgrp_max(mx); const float mo = mc[a], mn = fmaxf(mo, mx), mu = (mn == -INFINITY) ? 0.f : mn; float rs = 0.f;
#pragma unroll
                    for (int nb = 0; nb < 4; ++nb)
#pragma unroll
                        for (int j = 0; j < 4; ++j) rs += __builtin_amdgcn_exp2f(s[a][nb][j] - mu);
                    rs = rowgrp_sum(rs); zc[a] = zc[a] * __builtin_amdgcn_exp2f(mo - mu) + rs; mc[a] = mn; } });
        { float gtc[2], mu2[2], inv2[2];
#pragma unroll
          for (int a = 0; a < 2; ++a) { const int c_ = opq(c); const int qc = 8 * F.wave + 4 * a + (c_ >> 2); gtc[a] = sigmoidf_(bf2f(gbase[(unsigned)(qc * LDP + (g * 4 + (c_ & 3)) * 3 + 0)])); mu2[a] = (mc[a] == -INFINITY) ? 0.f : mc[a]; inv2[a] = zc[a] > 0.f ? 1.0f / zc[a] : 0.f; }
          tile_pipeline<true, true>(F, ntile, 128, 256,
            [&](int ti, const bf16_t*& kp, const bf16_t*& vp, int& pos0) { pos0 = 64 * ti; kp = kc + (size_t)pos0 * 128; vp = vc + (size_t)pos0 * 128; },
            [&](int ti, ldsp KT, ldsp VT) { f32x4 s[2][4]; scores2(F, KT, s); cmp_mask_scale(ti, s);
#pragma unroll
                for (int a = 0; a < 2; ++a) { const int qc = 8 * F.wave + 4 * a + (c >> 2);
#pragma unroll
                    for (int nb = 0; nb < 4; ++nb) { float p4 = 0.f;
#pragma unroll
                        for (int j = 0; j < 4; ++j) { const float p = __builtin_amdgcn_exp2f(s[a][nb][j] - mu2[a]) * inv2[a]; s[a][nb][j] = p; p4 += p; }
                        float p3 = s[a][nb][3];
                        p4 += __shfl_xor(p4, 1); p4 += __shfl_xor(p4, 2); p3 += __shfl_xor(p3, 1); p3 += __shfl_xor(p3, 2);
                        const int jj = 16 * ti + 4 * nb + g4;
                        if ((c & 3) == 0 && p4 != 0.f) __hip_atomic_fetch_add(&IMP[qc * 64 + jj], p4, __ATOMIC_RELAXED, __HIP_MEMORY_SCOPE_WORKGROUP);
                        if ((c & 3) == 0 && jj + 1 < 64 && p3 != 0.f) __hip_atomic_fetch_add(&IMP[qc * 64 + jj + 1], p3, __ATOMIC_RELAXED, __HIP_MEMORY_SCOPE_WORKGROUP); } }
                pv2(F, VT, s, gtc, o); }); }
        __syncthreads();
        { LAS unsigned* IMPU = (LAS unsigned*)IMP; const int j = F.lane; const bool valid = j <= cur, forced = (j == 0) || (j == cur) || (j + 1 == cur);
          unsigned myk[8];
#pragma unroll
          for (int qi = 0; qi < 8; ++qi) { const int qq = 8 * F.wave + qi; const unsigned bits = IMPU[qq * 64 + j];
              myk[qi] = !valid ? 0u : (((forced ? 0xFFFFFFC0u : ((bits & ~63u) | 0x80000000u))) | (unsigned)(63 - j)); IMPU[qq * 64 + j] = myk[qi]; }
          LDS_FENCE();
#pragma unroll
          for (int qi = 0; qi < 8; ++qi) { const int qq = 8 * F.wave + qi; int rank = 0;
#pragma unroll
              for (int i4 = 0; i4 < 16; ++i4) { const u32x4 k4 = *(LAS u32x4*)(IMPU + qq * 64 + 4 * i4); rank += (k4.x > myk[qi]) + (k4.y > myk[qi]) + (k4.z > myk[qi]) + (k4.w > myk[qi]); }
              const unsigned long long msk = __ballot(valid && rank < 8);
              if (F.lane == 0) SEL[qq] = msk; } }
        __syncthreads();
        unsigned long long uni = SEL[F.lane];
#pragma unroll
        for (int o_ = 32; o_ >= 1; o_ >>= 1) { const unsigned lo = __shfl_xor((unsigned)uni, o_), hi = __shfl_xor((unsigned)(uni >> 32), o_); uni |= ((unsigned long long)hi << 32) | lo; }
        const unsigned long long U = ((unsigned long long)(unsigned)__builtin_amdgcn_readfirstlane((int)(uni >> 32)) << 32) | (unsigned)__builtin_amdgcn_readfirstlane((int)uni);
        const unsigned long long sel0 = SEL[8 * F.wave + (c >> 2)], sel1 = SEL[8 * F.wave + 4 + (c >> 2)];
        unsigned long long w0 = 0ull, w1 = 0ull;
#pragma unroll
        for (int qi = 0; qi < 4; ++qi) { w0 |= SEL[8 * F.wave + qi]; w1 |= SEL[8 * F.wave + 4 + qi]; }
        const unsigned long long MB0 = ((unsigned long long)(unsigned)__builtin_amdgcn_readfirstlane((int)(w0 >> 32)) << 32) | (unsigned)__builtin_amdgcn_readfirstlane((int)w0);
        const unsigned long long MB1 = ((unsigned long long)(unsigned)__builtin_amdgcn_readfirstlane((int)(w1 >> 32)) << 32) | (unsigned)__builtin_amdgcn_readfirstlane((int)w1);
        int jlist;
        { const int j = F.lane; const bool has = (U >> j) & 1ull; const int r = __popcll(U & ((1ull << j) - 1ull)); const int dst = has ? r : 63 - (j - r);
          jlist = __builtin_amdgcn_ds_permute(dst * 4, j); }
        u32x4* const scr = (u32x4*)(MIX + (size_t)ui * 32768) + (unsigned)(F.wave * 2 * 64 * 4);
        { const int l_ = opq(F.lane);
#pragma unroll
          for (int a = 0; a < 2; ++a)
#pragma unroll
            for (int q4 = 0; q4 < 4; ++q4) { u32x4 w; w.x = pk2(o[a][2 * q4][0], o[a][2 * q4][1]); w.y = pk2(o[a][2 * q4][2], o[a][2 * q4][3]); w.z = pk2(o[a][2 * q4 + 1][0], o[a][2 * q4 + 1][1]); w.w = pk2(o[a][2 * q4 + 1][2], o[a][2 * q4 + 1][3]);
                scr[(a * 64 + l_) * 4 + q4] = w; } }
#define N2_FOLD(br, LAST) do { const int l_ = opq(F.lane); const int c = l_ & 15, g4 = l_ >> 4; u32x4 pv_[2][4]; \
            _Pragma("unroll") for (int a = 0; a < 2; ++a) _Pragma("unroll") for (int q4 = 0; q4 < 4; ++q4) pv_[a][q4] = scr[(a * 64 + l_) * 4 + q4]; \
            _Pragma("unroll") for (int a = 0; a < 2; ++a) { const int qr = 8 * F.wave + 4 * a + g4; float w_[4]; \
                _Pragma("unroll") for (int j = 0; j < 4; ++j) { const float zj = __shfl(zsw[a], (l_ & 48) | (4 * g4 + j)); const float gj = sigmoidf_(bf2f(gbase[(unsigned)(qr * LDP + (g * 4 + j) * 3 + (br))])); w_[j] = zj > 0.f ? gj / zj : 0.f; } \
                _Pragma("unroll") for (int q4 = 0; q4 < 4; ++q4) { const unsigned pw_[4] = {pv_[a][q4].x, pv_[a][q4].y, pv_[a][q4].z, pv_[a][q4].w}; float val_[2][4]; \
                    _Pragma("unroll") for (int h = 0; h < 2; ++h) { const int ne = 2 * q4 + h; \
                        val_[h][0] = bflo(pw_[2 * h]) + w_[0] * o[a][ne][0]; val_[h][1] = bfhi(pw_[2 * h]) + w_[1] * o[a][ne][1]; val_[h][2] = bflo(pw_[2 * h + 1]) + w_[2] * o[a][ne][2]; val_[h][3] = bfhi(pw_[2 * h + 1]) + w_[3] * o[a][ne][3]; } \
                    if (LAST) { _Pragma("unroll") for (int h = 0; h < 2; ++h) _Pragma("unroll") for (int j = 0; j < 4; ++j) \
                        ((unsigned char*)(F.ws + WS_MIX8) + row0 * DM + g * 512)[(unsigned)(qr * DM + j * 128 + c) + 16 * (2 * q4 + h)] = f2fp8(val_[h][j] * ACT8_SCALE); } \
                    else { u32x4 w; w.x = pk2(val_[0][0], val_[0][1]); w.y = pk2(val_[0][2], val_[0][3]); w.z = pk2(val_[1][0], val_[1][1]); w.w = pk2(val_[1][2], val_[1][3]); scr[(a * 64 + l_) * 4 + q4] = w; } } } } while (0)
        for (int rep_ = 0; rep_ < PROBE_B2; ++rep_) {
        N2_RESET();
        { const bf16_t* kb = PROJ + (size_t)b * SEQ * LDP + C_NKS + g * 128; const bf16_t* vbp = PROJ + (size_t)b * SEQ * LDP + C_NVS + g * 128;
          tile_pipeline<true, true>(F, __popcll(U), LDP, SEQ,
            [&](int ti, const bf16_t*& kp, const bf16_t*& vp, int& pos0) { const int jb = __builtin_amdgcn_readlane(jlist, ti); pos0 = 64 * jb; kp = kb + (size_t)pos0 * LDP; vp = vbp + (size_t)pos0 * LDP; },
            [&](int ti, ldsp KT, ldsp VT) { const int jb = __builtin_amdgcn_readlane(jlist, ti);
                const bool a0 = (MB0 >> jb) & 1ull, a1 = (MB1 >> jb) & 1ull, r0 = (sel0 >> jb) & 1ull, r1 = (sel1 >> jb) & 1ull;
                if (jb == cur) attn_tile3<true, true, 1>(F, KT, VT, o, msw, zsw, scale2, true, true);
                else if (a0 && a1) attn_tile3<true, true, 0>(F, KT, VT, o, msw, zsw, scale2, r0, r1);
                else if (a0) attn_tile3<true, false, 0>(F, KT, VT, o, msw, zsw, scale2, r0, r1);
                else if (a1) attn_tile3<false, true, 0>(F, KT, VT, o, msw, zsw, scale2, r0, r1); }); }
        }
        N2_FOLD(1, true);
#undef N2_FOLD
#undef N2_RESET
#undef N2_ZERO_O
    }
    __syncthreads();
}
#ifndef STOP
#define STOP 99
#endif
#ifndef PER_PHASE_LAUNCH
#define PER_PHASE_LAUNCH 0
#endif
struct Args { const float* in[25]; float* out; unsigned char* ws; int ph_lo, ph_hi; };
__device__ __forceinline__ void norm_f32_phase(const Frame& F0, const float* src, const float* w, float* dst) { PHASE_FRAME(F0);
    for (int row = F.bid * NWAVE + F.wave; row < MTOK; row += F.G * NWAVE) {
        const float4* p = (const float4*)(src + (size_t)row * DM); float4 v[8]; float ss = 0.f;
#pragma unroll
        for (int i = 0; i < 8; ++i) { v[i] = p[F.lane + 64 * i]; ss += v[i].x * v[i].x + v[i].y * v[i].y + v[i].z * v[i].z + v[i].w * v[i].w; }
        ss = wave_sum(ss); const float rstd = rsqrtf(ss * (1.0f / DM) + RMS_EPS);
#pragma unroll
        for (int i = 0; i < 8; ++i) { const float4 g = ((const float4*)w)[F.lane + 64 * i]; float4 o; o.x = v[i].x * rstd * g.x; o.y = v[i].y * rstd * g.y; o.z = v[i].z * rstd * g.z; o.w = v[i].w * rstd * g.w;
            ((float4*)(dst + (size_t)row * DM))[F.lane + 64 * i] = o; }
    }
}

#if defined(MXTEST)
typedef int v8i_t __attribute__((ext_vector_type(8)));
__device__ __forceinline__ int mx_val(int i, int k) { return ((i * 7 + k * 13 + (i * k) % 5) % 7) - 3; }
__device__ __forceinline__ unsigned mx_fp8(int v) { const unsigned char t[7] = {0xC4, 0xC0, 0xB8, 0x00, 0x38, 0x40, 0x44}; return t[v + 3]; }
__device__ void mx_selftest(float* out) {
    const int lane = threadIdx.x & 63, r = lane & 15, kb = lane >> 4;
    f32x4 ref = (f32x4){0.f, 0.f, 0.f, 0.f};
    for (int ks = 0; ks < 4; ++ks) { bf16x8 a, b;
        for (int j = 0; j < 8; ++j) { const int k = 32 * ks + 8 * kb + j; a[j] = (short)f2bf((float)mx_val(r, k)); b[j] = (short)f2bf((float)mx_val(k, r + 16)); }
        ref = mfma16(a, b, ref); }
    for (int hyp = 0; hyp < 3; ++hyp) {
        v8i_t A, B;
        for (int w = 0; w < 8; ++w) { unsigned wa = 0, wb = 0;
            for (int by = 0; by < 4; ++by) { const int t = 4 * w + by; int k;
                if (hyp == 0) k = 32 * kb + t; else if (hyp == 1) k = (t < 16) ? 16 * kb + t : 64 + 16 * kb + (t - 16); else k = 8 * kb + (t & 7) + 32 * (t >> 3);
                wa |= mx_fp8(mx_val(r, k)) << (8 * by); wb |= mx_fp8(mx_val(k, r + 16)) << (8 * by); }
            A[w] = (int)wa; B[w] = (int)wb; }
        f32x4 acc = (f32x4){0.f, 0.f, 0.f, 0.f};
        acc = __builtin_amdgcn_mfma_scale_f32_16x16x128_f8f6f4(A, B, acc, 0, 0, 0, 0x7f7f7f7f, 0, 0x7f7f7f7f);
        const bool bad = (acc[0] != ref[0]) || (acc[1] != ref[1]) || (acc[2] != ref[2]) || (acc[3] != ref[3]);
        if (__builtin_amdgcn_ballot_w64(bad) != 0ull && lane == 0) out[hyp] = (hyp == 0) ? 1e4f : (hyp == 1) ? 3e4f : 9e4f;
    }
}
#endif
constexpr int N_PHASES = 25;
__global__ void __launch_bounds__(NTHR, 2) fwd_kernel(Args args) {
    extern __shared__ __attribute__((aligned(16))) unsigned char lds_raw[];
    Frame F;
#pragma unroll
    for (int i = 0; i < 25; ++i) F.in[i] = args.in[i];
    F.out = args.out; F.ws = args.ws; F.lds = (ldsp)lds_raw;
    F.tid = threadIdx.x; F.lane = F.tid & 63; F.wave = __builtin_amdgcn_readfirstlane(F.tid >> 6); F.G = gridDim.x; F.bid = blockIdx.x;
    volatile LAS unsigned* misc = (volatile LAS unsigned*)(F.lds + LDS_BYTES - 64);
    for (int i = F.tid; i < LDS_BYTES / 16; i += NTHR) *(LAS u32x4*)(F.lds + 16 * i) = (u32x4){0u, 0u, 0u, 0u};
    __syncthreads();
    XcdBarrier bar; bar.bar = (unsigned*)(F.ws + WS_CTL); bar.x = 0; bar.st = nullptr;
    if (!PER_PHASE_LAUNCH) bar = xcd_barrier_post((unsigned*)(F.ws + WS_CTL), misc);
    const int lo = args.ph_lo, hi = args.ph_hi;
#define IN(k) (lo <= (k) && (k) < hi)
#define SEAM(k) do { if (!PER_PHASE_LAUNCH && IN((k) + 1)) xcd_barrier(bar); } while (0)
    ldsp gl = F.lds;
    bf16_t* HN = (bf16_t*)(F.ws + WS_HN); bf16_t* PROJ = (bf16_t*)(F.ws + WS_PROJ); bf16_t* MIX = (bf16_t*)(F.ws + WS_MIX);

#if defined(DBL_CVT)
    if (IN(0)) { p0_prologue(F); __syncthreads(); p0_prologue(F); SEAM(0); }
#else
    if (IN(0)) { for (int r_ = 0; r_ < PROBE_REP(P0); ++r_) { p0_prologue(F); __syncthreads(); } SEAM(0); }
#endif
#if STOP >= 1
    if (IN(1)) {
        { pg8::Gemm g{HN, (const bf16_t*)(F.ws + WS_WAB_IN), MTOK, IN0_BF, DM}; pg8::StaticOrder S; S.init(MTOK, IN0_BF, F.G, F.bid); pg8::EpiBf16P E{PROJ, LDP, 1.0f};
          pg8::gemm_phase<pg8::EpiBf16P, pg8::StaticOrder, true, true, false, false>(gl, g, S, E); }
        { pg8::Gemm g{(const bf16_t*)(F.ws + WS_HN8), (const bf16_t*)(F.ws + WS_WAB_IN + (size_t)IN0_BF * DM * 2), MTOK, NAB - IN0_BF, DM}; pg8::StaticOrder S; S.init(MTOK, NAB - IN0_BF, F.G, F.bid); pg8::EpiBf16P E{PROJ + IN0_BF, LDP, 0.03125f};
          pg8::gemm_phase<pg8::EpiBf16P, pg8::StaticOrder, true, true, false, true>(gl, g, S, E); }
        SEAM(1); }
#if !defined(PROBE_REP)
#define PROBE_REP(name) 1
#endif
    if (IN(2)) { for (int r_ = 0; r_ < PROBE_REP(HS1); ++r_) hgrn_s1_phase(F); for (int r_ = 0; r_ < PROBE_REP(SWA); ++r_) swa_phase(F); SEAM(2); }
    if (IN(3)) { for (int r_ = 0; r_ < PROBE_REP(HSC); ++r_) hgrn_scan_phase(F); SEAM(3); }
    if (IN(4)) { for (int r_ = 0; r_ < PROBE_REP(HS3); ++r_) hgrn_s3_phase(F); SEAM(4); }
    if (IN(5)) { pg8::Gemm g{OUT_FP8 ? (const bf16_t*)(F.ws + WS_MIX8) : MIX, (const bf16_t*)(F.ws + WS_WAB_OUT), MTOK, DM, DM}; pg8::StaticOrder S; S.init(MTOK, DM, F.G, F.bid); pg8::EpiResBf16<true> E{F.in[0], (bf16_t*)F.out, DM, OUT_FP8 ? ACT8_DESCALE : 1.0f};
        for (int r_ = 0; r_ < PROBE_REP(G5); ++r_) pg8::gemm_phase<pg8::EpiResBf16<true>, pg8::StaticOrder, true, true, false, OUT_FP8>(gl, g, S, E); SEAM(5); }
#endif
#if STOP >= 2
    if (IN(6)) { norm_route_phase(F, 0, F.in[2]); SEAM(8); }
    if (IN(9)) { gather_phase(F, 0); SEAM(9); }
    if (IN(10)) { const int RT = (int)((const unsigned*)(F.ws + WS_CTL))[CW_RT + 0];
        pg8::MoeOrder S; S.initm(RT, F.G, F.bid, (const int*)(F.ws + WS_TEXP));
        if constexpr (MOE_FP8) { pg8::Gemm g{(const bf16_t*)(F.ws + WS_HN8), (const bf16_t*)(F.ws + WS_W1), RT * 256, 2048, DM}; pg8::EpiSwiGLU8 E{(unsigned char*)(F.ws + WS_HID)};
            for (int r_ = 0; r_ < PROBE_REP(G10); ++r_) pg8::gemm_phase<pg8::EpiSwiGLU8, pg8::MoeOrder, true, true, true, true>(gl, g, S, E, (const int*)(F.ws + WS_ROWTOK)); }
        else { pg8::Gemm g{HN, (const bf16_t*)(F.ws + WS_W1), RT * 256, 2048, DM}; pg8::EpiSwiGLU E{(bf16_t*)(F.ws + WS_HID)};
            pg8::gemm_phase<pg8::EpiSwiGLU, pg8::MoeOrder, true, true, true>(gl, g, S, E, (const int*)(F.ws + WS_ROWTOK)); } SEAM(10); }
    if (IN(11)) { const int RT = (int)((const unsigned*)(F.ws + WS_CTL))[CW_RT + 0];
        pg8::Gemm g{(const bf16_t*)(F.ws + WS_HID), (const bf16_t*)(F.ws + WS_W2), RT * 256, 2048, DFF}; pg8::MoeOrder S; S.initm(RT, F.G, F.bid, (const int*)(F.ws + WS_TEXP));
        if constexpr (MOE_FP8) { pg8::EpiMoeDown88 E{(unsigned char*)(F.ws + WS_XS), DM}; for (int r_ = 0; r_ < PROBE_REP(G11); ++r_) pg8::gemm_phase<pg8::EpiMoeDown88, pg8::MoeOrder, true, true, false, true>(gl, g, S, E); }
        else { pg8::EpiMoeDown E{(bf16_t*)(F.ws + WS_XS), DM}; pg8::gemm_phase<pg8::EpiMoeDown, pg8::MoeOrder, true, true>(gl, g, S, E); } SEAM(11); }
#endif
#if STOP >= 3
#if defined(DBL_CVT)
    if (IN(12)) { combine_phase<false>(F, F.in[1] + DM); int rr = 0; convert_moe_layer(F, 1, rr); rr = 0; convert_moe_layer(F, 1, rr); SEAM(12); }
#else
    if (IN(12)) { combine_phase<false>(F, F.in[1] + DM); if (CVT_WG == 0) { for (int r_ = 0; r_ < PROBE_REP(C12); ++r_) { int rr = 0; convert_moe_layer(F, 1, rr); } } SEAM(12); }
#endif
    if (IN(13)) { const int GG = (CVT_WG > 0 && F.G > 2 * CVT_WG) ? F.G - CVT_WG : F.G;
        if (F.bid >= GG) { Frame F2 = F; F2.G = F.G - GG; F2.bid = F.bid - GG; int rr = 0; convert_moe_layer(F2, 1, rr); }
        else {
        pg8::Gemm g{IN1_FP8 ? (const bf16_t*)(F.ws + WS_HN8) : HN, (const bf16_t*)(F.ws + WS_WCD_IN), MTOK, NCD, DM}; pg8::StaticOrder S; S.init(MTOK, NCD, GG, F.bid); pg8::EpiBf16P E{PROJ, LDP, IN1_FP8 ? 0.03125f : 1.0f};
        for (int r_ = 0; r_ < PROBE_REP(G13); ++r_) pg8::gemm_phase<pg8::EpiBf16P, pg8::StaticOrder, true, true, false, IN1_FP8>(gl, g, S, E); }
        if (F.G == GG && CVT_WG > 0) { int rr = 0; convert_moe_layer(F, 1, rr); }
        SEAM(13); }
    if (IN(14)) { for (int r_ = 0; r_ < PROBE_REP(CMP); ++r_) nsa_compress_phase(F); for (int r_ = 0; r_ < PROBE_REP(RS1); ++r_) ret_s1_phase(F); SEAM(14); }
    if (IN(15)) { for (int r_ = 0; r_ < PROBE_REP(RSC); ++r_) ret_scan_phase(F); SEAM(15); }
    if (IN(16)) { for (int r_ = 0; r_ < PROBE_REP(NSA); ++r_) nsa_attn_phase(F); for (int r_ = 0; r_ < PROBE_REP(RS3); ++r_) ret_s3_phase(F); SEAM(16); }
    if (IN(17)) { pg8::Gemm g{OUT_FP8 ? (const bf16_t*)(F.ws + WS_MIX8) : MIX, (const bf16_t*)(F.ws + WS_WCD_OUT), MTOK, DM, DM}; pg8::StaticOrder S; S.init(MTOK, DM, F.G, F.bid); pg8::EpiResBf16<false> E{(const bf16_t*)F.out, (bf16_t*)(F.ws + WS_PROJ), DM, OUT_FP8 ? ACT8_DESCALE : 1.0f};
        pg8::gemm_phase<pg8::EpiResBf16<false>, pg8::StaticOrder, true, true, false, OUT_FP8>(gl, g, S, E);
#if PROBE_G17 > 1
        pg8::gemm_phase<pg8::EpiResBf16<false>, pg8::StaticOrder, true, true, false, OUT_FP8>(gl, g, S, E);
        pg8::gemm_phase<pg8::EpiResBf16<false>, pg8::StaticOrder, true, true, false, OUT_FP8>(gl, g, S, E);
#endif
        SEAM(17); }
#endif
#if STOP >= 4
    if (IN(18)) { norm_route_phase(F, 1, F.in[2] + DM); SEAM(20); }
    if (IN(21)) { gather_phase(F, 1); SEAM(21); }
    if (IN(22)) { const int RT = (int)((const unsigned*)(F.ws + WS_CTL))[CW_RT + 1];
        pg8::MoeOrder S; S.initm(RT, F.G, F.bid, (const int*)(F.ws + WS_TEXP));
        if constexpr (MOE_FP8) { pg8::Gemm g{(const bf16_t*)(F.ws + WS_HN8), (const bf16_t*)(F.ws + WS_W1), RT * 256, 2048, DM}; pg8::EpiSwiGLU8 E{(unsigned char*)(F.ws + WS_HID)};
            pg8::gemm_phase<pg8::EpiSwiGLU8, pg8::MoeOrder, true, true, true, true>(gl, g, S, E, (const int*)(F.ws + WS_ROWTOK)); }
        else { pg8::Gemm g{HN, (const bf16_t*)(F.ws + WS_W1), RT * 256, 2048, DM}; pg8::EpiSwiGLU E{(bf16_t*)(F.ws + WS_HID)};
            pg8::gemm_phase<pg8::EpiSwiGLU, pg8::MoeOrder, true, true, true>(gl, g, S, E, (const int*)(F.ws + WS_ROWTOK)); } SEAM(22); }
    if (IN(23)) { const int RT = (int)((const unsigned*)(F.ws + WS_CTL))[CW_RT + 1];
        pg8::Gemm g{(const bf16_t*)(F.ws + WS_HID), (const bf16_t*)(F.ws + WS_W2), RT * 256, 2048, DFF}; pg8::MoeOrder S; S.initm(RT, F.G, F.bid, (const int*)(F.ws + WS_TEXP));
        if constexpr (MOE_FP8) { pg8::EpiMoeDown88 E{(unsigned char*)(F.ws + WS_XS), DM}; pg8::gemm_phase<pg8::EpiMoeDown88, pg8::MoeOrder, true, true, false, true>(gl, g, S, E); }
        else { pg8::EpiMoeDown E{(bf16_t*)(F.ws + WS_XS), DM}; pg8::gemm_phase<pg8::EpiMoeDown, pg8::MoeOrder, true, true>(gl, g, S, E); } SEAM(23); }
#endif
#if defined(MXTEST)
    if (IN(24) && F.bid == 0 && F.tid < 64) { __builtin_amdgcn_s_sleep(1); }
#endif
    if (IN(24)) {
#if STOP == 0
        norm_f32_phase(F, F.in[0], F.in[3], F.out);
#elif STOP == 1 || STOP == 3
        norm_f32_phase(F, F.out, F.in[3], F.out);
#else
        for (int r_ = 0; r_ < PROBE_REP(CMB); ++r_) combine_phase<true>(F, F.in[3]);
#endif
    }
#if defined(MXTEST)
    __syncthreads();
    if (hi == N_PHASES) { xcd_barrier(bar); if (F.bid == 0 && F.tid < 64) mx_selftest(F.out); }
#endif
#undef IN
#undef SEAM
}


#if defined(DETCHK)
__global__ void checksum_kernel(const unsigned* p, size_t nwords, unsigned long long* dst) {
    unsigned long long s = 0; for (size_t i = (size_t)blockIdx.x * blockDim.x + threadIdx.x; i < nwords; i += (size_t)gridDim.x * blockDim.x) s += (unsigned long long)p[i] * (unsigned long long)((i & 1023) + 1);
    for (int o = 32; o >= 1; o >>= 1) s += __shfl_xor(s, o);
    if ((threadIdx.x & 63) == 0) atomicAdd(dst, s);
}
__global__ void compare_kernel(const unsigned long long* cs, int n, float* out) {
    if (threadIdx.x == 0 && blockIdx.x == 0) { for (int k = 0; k < n; ++k) if (cs[k] != cs[32 + k]) { float v = 1e4f; for (int i = 0; i < k; ++i) v *= 3.1622776f; out[0] = v; break; } }
}
__global__ void checksum2d_kernel(const unsigned* p, int rows, int pitchw, int c0w, int ncw, unsigned long long* dst) {
    unsigned long long s = 0; const size_t n = (size_t)rows * ncw;
    for (size_t i = (size_t)blockIdx.x * blockDim.x + threadIdx.x; i < n; i += (size_t)gridDim.x * blockDim.x) { const size_t r = i / ncw, c = i % ncw; s += (unsigned long long)p[r * pitchw + c0w + c] * (unsigned long long)((i & 1023) + 1); }
    for (int o = 32; o >= 1; o >>= 1) s += __shfl_xor(s, o);
    if ((threadIdx.x & 63) == 0) atomicAdd(dst, s);
}
__global__ void checksum_rowsel_kernel(const unsigned* p, int rows, int pitchw, int c0w, int ncw, int want_n0, unsigned long long* dst) {
    unsigned long long s = 0; const size_t n = (size_t)rows * ncw;
    for (size_t i = (size_t)blockIdx.x * blockDim.x + threadIdx.x; i < n; i += (size_t)gridDim.x * blockDim.x) { const size_t r = i / ncw, c = i % ncw; const bool n0 = ((r >> 7) & 31) == 0;
        if (n0 == (want_n0 != 0)) s += (unsigned long long)p[r * pitchw + c0w + c] * (unsigned long long)((i & 1023) + 1); }
    for (int o = 32; o >= 1; o >>= 1) s += __shfl_xor(s, o);
    if ((threadIdx.x & 63) == 0) atomicAdd(dst, s);
}
__global__ void compare2_kernel(const unsigned long long* cs, float* out) {
    if (threadIdx.x == 0 && blockIdx.x == 0) { if (cs[20] != cs[21] || cs[52] != cs[53]) out[0] = 1e4f; if (cs[21] != cs[53]) out[1] = 3e4f; if (cs[22] != cs[23] || cs[54] != cs[55] || cs[23] != cs[55]) out[2] = 9e4f; }
}
struct Chk { int after_phase; size_t off; size_t bytes; int in_out; };
#endif
extern "C" void kernel_launch(void* const* d_in, const int* in_sizes, int n_in, void* d_out, int out_size, void* d_ws, size_t ws_size, hipStream_t stream) {
    static int grid = 0;
    if (grid == 0) {
        if (n_in != 25 || out_size != MTOK * DM || ws_size < WS_END) { fprintf(stderr, "kernel_launch: unexpected shapes (n_in %d out %d ws %zu need %zu)\n", n_in, out_size, ws_size, (size_t)WS_END); grid = -1; return; }
        int dev = 0, cus = 0, per_cu = 0;
        if (hipGetDevice(&dev) != hipSuccess || hipDeviceGetAttribute(&cus, hipDeviceAttributeMultiprocessorCount, dev) != hipSuccess) { grid = -1; return; }
        if (hipFuncSetAttribute((const void*)fwd_kernel, hipFuncAttributeMaxDynamicSharedMemorySize, LDS_BYTES) != hipSuccess) { fprintf(stderr, "kernel_launch: hipFuncSetAttribute failed\n"); grid = -1; return; }
        if (hipOccupancyMaxActiveBlocksPerMultiprocessor(&per_cu, (const void*)fwd_kernel, NTHR, LDS_BYTES) != hipSuccess || per_cu < 1) { fprintf(stderr, "kernel_launch: occupancy query says %d\n", per_cu); (void)hipGetLastError(); grid = -1; return; }
        grid = cus;
    }
    if (grid < 0) return;
    (void)hipMemsetAsync((char*)d_ws + WS_CTL, 0, CTL_BYTES, stream);
    Args a{};
    for (int i = 0; i < 25; ++i) a.in[i] = (const float*)d_in[i];
    a.out = (float*)d_out; a.ws = (unsigned char*)d_ws;
#if PER_PHASE_LAUNCH && defined(DETCHK)
    static const Chk chks[] = { {0, WS_HN, (size_t)MTOK * DM * 2, 0}, {2, WS_DS, (size_t)4096 * 16384 * 4, 0}, {3, WS_SPREV, (size_t)4096 * 16384 * 2, 0}, {4, WS_MIX, (size_t)MTOK * DM * 2, 0},
        {5, 0, (size_t)MTOK * DM * 4, 1}, {7, WS_LOG, (size_t)MTOK * 256 * 4, 0}, {8, WS_RTE, (size_t)MTOK * 16, 0}, {12, 0, (size_t)MTOK * DM * 4, 1}, {13, WS_PROJ, (size_t)MTOK * LDP * 2, 0},
        {14, WS_KCMP, (size_t)2 * 8 * 2 * 256 * 128 * 2, 0}, {15, WS_RPREV, (size_t)1024 * 32768 * 2, 0}, {16, WS_MIX, 1, 2}, {16, WS_MIX, 2, 2}, {17, 0, (size_t)MTOK * DM * 4, 1}, {19, WS_LOG, (size_t)MTOK * 256 * 4, 0}, {20, WS_RTE, (size_t)MTOK * 16, 0}, {24, 0, (size_t)MTOK * DM * 4, 1} };
    const int nchk = (int)(sizeof(chks) / sizeof(chks[0]));
    unsigned long long* cs = (unsigned long long*)((char*)d_ws + WS_CTL + 32768);
    (void)hipMemsetAsync((char*)d_ws + CTL_BYTES, 0xAA, ws_size - CTL_BYTES, stream);
    (void)hipMemsetAsync(d_out, 0xAA, (size_t)MTOK * DM * 4, stream);
    for (int run = 0; run < 2; ++run) {
        if (run == 1) (void)hipMemsetAsync((char*)d_ws + WS_CTL + 16384, 0, 2048, stream);
        for (int ph = 0; ph < N_PHASES; ++ph) { a.ph_lo = ph; a.ph_hi = ph + 1; hipLaunchKernelGGL(fwd_kernel, dim3(grid), dim3(NTHR), LDS_BYTES, stream, a);
            if (ph == 16) { hipLaunchKernelGGL(checksum2d_kernel, dim3(1024), dim3(256), 0, stream, (const unsigned*)((char*)d_ws + WS_MIX), MTOK, 1024, 512, 512, cs + run * 32 + 20);
                hipLaunchKernelGGL(checksum2d_kernel, dim3(1024), dim3(256), 0, stream, (const unsigned*)((char*)d_ws + WS_MIX), MTOK, 1024, 0, 512, cs + run * 32 + 22);
                hipLaunchKernelGGL(fwd_kernel, dim3(grid), dim3(NTHR), LDS_BYTES, stream, a);
                hipLaunchKernelGGL(checksum2d_kernel, dim3(1024), dim3(256), 0, stream, (const unsigned*)((char*)d_ws + WS_MIX), MTOK, 1024, 512, 512, cs + run * 32 + 21);
                hipLaunchKernelGGL(checksum2d_kernel, dim3(1024), dim3(256), 0, stream, (const unsigned*)((char*)d_ws + WS_MIX), MTOK, 1024, 0, 512, cs + run * 32 + 23); }
            for (int k = 0; k < nchk; ++k) if (chks[k].after_phase == ph) { if (chks[k].in_out == 2) { hipLaunchKernelGGL(checksum2d_kernel, dim3(1024), dim3(256), 0, stream, (const unsigned*)((char*)d_ws + WS_MIX), MTOK, 1024, chks[k].bytes == 1 ? 0 : 512, 512, cs + run * 32 + k); continue; } const unsigned* p = chks[k].in_out ? (const unsigned*)d_out : (const unsigned*)((char*)d_ws + chks[k].off);
                hipLaunchKernelGGL(checksum_kernel, dim3(1024), dim3(256), 0, stream, p, chks[k].bytes / 4, cs + run * 32 + k); } }
    }
    hipLaunchKernelGGL(compare2_kernel, dim3(1), dim3(64), 0, stream, (const unsigned long long*)cs, (float*)d_out);
#elif PER_PHASE_LAUNCH
    for (int ph = 0; ph < N_PHASES; ++ph) { a.ph_lo = ph; a.ph_hi = ph + 1; hipLaunchKernelGGL(fwd_kernel, dim3(grid), dim3(NTHR), LDS_BYTES, stream, a); }
#else
    a.ph_lo = 0; a.ph_hi = N_PHASES;
    hipLaunchKernelGGL(fwd_kernel, dim3(grid), dim3(NTHR), LDS_BYTES, stream, a);
#endif
}
```
